# Optimizing an MI355X kernel written in HIP

```python
import math
import jax, jax.numpy as jnp
from jax import lax
import numpy as np

D_MODEL = 1024
BATCH = 8
SEQ = 2048
DEPTH = 2

GRID_W = 64
CTX_LEN = 256
RMS_EPS = 1e-6
N_MOD = 9
D_FF = 2816
POOL_WINDOWS = (2, 4, 8, 16)
POOL_GROUPS = len(POOL_WINDOWS)
POOL_DIM = D_MODEL // 2
POOL_GROUP_DIM = POOL_DIM // POOL_GROUPS
MLA_HEADS = D_MODEL // 128
QK_NOPE_DIM = 64
QK_ROPE_DIM = 32
QK_HEAD_DIM = QK_NOPE_DIM + QK_ROPE_DIM
V_HEAD_DIM = 64
Q_LORA_RANK = 768
KV_LORA_RANK = 256
ROPE_AXIS_DIM = QK_ROPE_DIM // 2
ROPE_THETA = 10000.0
ATTN_SCALE = 1.0 / math.sqrt(QK_HEAD_DIM)
QBLOCK = 128
AB_IN_DIM = POOL_DIM + Q_LORA_RANK + KV_LORA_RANK + QK_ROPE_DIM
AB_OUT_DIM = POOL_DIM + MLA_HEADS * V_HEAD_DIM
CONV_DIM = D_MODEL
CONV_WIDTH = 3
N_EVEN = (DEPTH + 1) // 2
N_ODD = DEPTH // 2

kernel_name = 'hybrid_pool_mla_shortconv_dit_block'


def rmsnorm(x, g):
    xf = x.astype(jnp.float32)
    y = xf * lax.rsqrt(jnp.mean(xf * xf, axis=-1, keepdims=True) + RMS_EPS)
    return (y * g.astype(jnp.float32)).astype(x.dtype)


def modulation(cond, w, b):
    m = jax.nn.silu(cond) @ w + b
    return m.reshape(cond.shape[0], 1, N_MOD, cond.shape[-1])


def adaln(s, gain, m, k):
    shift, scale, gate = m[:, :, 3 * k], m[:, :, 3 * k + 1], m[:, :, 3 * k + 2]
    return rmsnorm(s, gain) * (1 + scale) + shift, gate


def swiglu(u, wg, wu, wd):
    return (jax.nn.silu(u @ wg) * (u @ wu)) @ wd


def ffn_half(s, m, k, gain, wg, wu, wd):
    u, gate = adaln(s, gain, m, k)
    return s + 0.5 * gate * swiglu(u, wg, wu, wd)


def multiscale_pool(u, w_grp, scale):
    b, l, _ = u.shape
    uf = u.astype(jnp.float32).reshape(b, l, POOL_GROUPS, POOL_GROUP_DIM)
    cs = jnp.concatenate([jnp.zeros_like(uf[:, :1]), jnp.cumsum(uf, axis=1)], axis=1)
    t = jnp.arange(l)
    outs = []
    for gi, w in enumerate(POOL_WINDOWS):
        lo = jnp.clip(t - w // 2, 0, l - 1)
        hi = jnp.clip(t + (w - w // 2 - 1), 0, l - 1)
        win_sum = cs[:, hi + 1, gi] - cs[:, lo, gi]
        cnt = (hi - lo + 1).astype(jnp.float32)[None, :, None]
        outs.append(win_sum / cnt - uf[:, :, gi])
    p = jnp.stack(outs, axis=2).astype(u.dtype)
    y = jnp.einsum('blgc,gcd->blgd', p, w_grp).reshape(b, l, POOL_DIM)
    return y * scale


def axial_rope_tables(length):
    rows = length // GRID_W
    row = jnp.repeat(jnp.arange(rows), GRID_W).astype(jnp.float32)
    col = jnp.tile(jnp.arange(GRID_W), rows).astype(jnp.float32)
    freqs = jnp.power(ROPE_THETA, -jnp.arange(0, ROPE_AXIS_DIM, 2, dtype=jnp.float32) / ROPE_AXIS_DIM)
    ang_r = (row[:, None] * freqs)[:, None, :]
    ang_c = (col[:, None] * freqs)[:, None, :]
    return (jnp.cos(ang_r), jnp.sin(ang_r), jnp.cos(ang_c), jnp.sin(ang_c))


def rot_half(z, cos, sin):
    h = z.shape[-1] // 2
    z1, z2 = z[..., :h], z[..., h:]
    return jnp.concatenate([z1 * cos - z2 * sin, z2 * cos + z1 * sin], axis=-1)


def apply_axial_rope(z, tabs):
    cos_r, sin_r, cos_c, sin_c = (tb.astype(z.dtype) for tb in tabs)
    return jnp.concatenate([rot_half(z[..., :ROPE_AXIS_DIM], cos_r, sin_r),
                            rot_half(z[..., ROPE_AXIS_DIM:], cos_c, sin_c)], axis=-1)


def mla_queries(cq, q_norm_g, w_uq):
    b, l, _ = cq.shape
    q = (rmsnorm(cq, q_norm_g) @ w_uq).reshape(b, l, MLA_HEADS, QK_HEAD_DIM)
    return q[..., :QK_NOPE_DIM], q[..., QK_NOPE_DIM:]


def mla_keys_values(ckv, kv_norm_g, w_ukv):
    b, l, _ = ckv.shape
    kv = (rmsnorm(ckv, kv_norm_g) @ w_ukv).reshape(b, l, MLA_HEADS, QK_NOPE_DIM + V_HEAD_DIM)
    return kv[..., :QK_NOPE_DIM], kv[..., QK_NOPE_DIM:]


def mla_attention(q_nope, q_rope, k_nope, k_rope, v):
    b, l, h, _ = q_nope.shape
    nb = l // QBLOCK

    def to_blocks(z):
        return z.reshape(b, nb, QBLOCK, h, z.shape[-1]).swapaxes(0, 1)

    def block(args):
        qn, qr = args
        s = (jnp.einsum('bqhd,bkhd->bhqk', qn, k_nope, preferred_element_type=jnp.float32)
             + jnp.einsum('bqhr,bkr->bhqk', qr, k_rope, preferred_element_type=jnp.float32))
        p = jax.nn.softmax(s * ATTN_SCALE, axis=-1).astype(v.dtype)
        return jnp.einsum('bhqk,bkhd->bqhd', p, v)

    o = lax.map(block, (to_blocks(q_nope), to_blocks(q_rope)))
    return o.swapaxes(0, 1).reshape(b, l, h * V_HEAD_DIM)


def pool_mla_mixer(uh, ug, tabs, w_in, pool_w, pool_scale, q_norm_g, w_uq, kv_norm_g, w_ukv, w_out, ctx_out):
    cuts = [POOL_DIM, POOL_DIM + Q_LORA_RANK, POOL_DIM + Q_LORA_RANK + KV_LORA_RANK]
    pool_h, cq_h, ckv_h, kr_h = jnp.split(uh @ w_in, cuts, axis=-1)
    pool_g, cq_g, ckv_g, kr_g = jnp.split(ug @ w_in, cuts, axis=-1)
    qn_h, qr_h = mla_queries(cq_h, q_norm_g, w_uq)
    qr_h = apply_axial_rope(qr_h, tabs)
    kn_h, v_h = mla_keys_values(ckv_h, kv_norm_g, w_ukv)
    kr_h = apply_axial_rope(kr_h[:, :, None, :], tabs)[:, :, 0]
    kn_g, v_g = mla_keys_values(ckv_g, kv_norm_g, w_ukv)
    attn_h = mla_attention(qn_h, qr_h,
                           jnp.concatenate([kn_h, kn_g], axis=1),
                           jnp.concatenate([kr_h, kr_g], axis=1),
                           jnp.concatenate([v_h, v_g], axis=1))
    out_h = jnp.concatenate([multiscale_pool(pool_h, pool_w, pool_scale), attn_h], axis=-1) @ w_out
    out_g = None
    if ctx_out:
        qn_g, qr_g = mla_queries(cq_g, q_norm_g, w_uq)
        attn_g = mla_attention(qn_g, qr_g, kn_g, kr_g, v_g)
        out_g = jnp.concatenate([multiscale_pool(pool_g, pool_w, pool_scale), attn_g], axis=-1) @ w_out
    return out_h, out_g


def short_conv_mixer(u, w_in, conv_w, w_out):
    b_gate, c_gate, val = jnp.split(u @ w_in, 3, axis=-1)
    z = c_gate * val
    z = lax.conv_general_dilated(z, conv_w[:, None, :].astype(z.dtype), window_strides=(1,),
                                 padding=((CONV_WIDTH // 2, CONV_WIDTH // 2),),
                                 dimension_numbers=('NWC', 'WIO', 'NWC'),
                                 feature_group_count=z.shape[-1])
    return (b_gate * z) @ w_out


def setup_inputs(seed: int = 0) -> dict:
    key = jax.random.key(seed)
    ks = jax.random.split(key, 24)

    def nrm(k, shape, scale):
        return jax.random.normal(k, shape, jnp.float32) * scale

    D, F = D_MODEL, D_FF
    return {
        'x': nrm(ks[0], (BATCH, SEQ, D), 1.0),
        'c': nrm(ks[1], (BATCH, D), 1.0),
        'ctx': nrm(ks[2], (BATCH, CTX_LEN, D), 1.0),
        'c_ctx': nrm(ks[3], (D,), 1.0),
        'norm_g': 1.0 + nrm(ks[4], (DEPTH, 3, D), 0.02),
        'w_mod': nrm(ks[5], (DEPTH, D, N_MOD * D), 0.5 * D ** -0.5),
        'b_mod': nrm(ks[6], (DEPTH, N_MOD * D), 0.02),
        'ffn_w_gate': nrm(ks[7], (DEPTH, 2, D, F), D ** -0.5),
        'ffn_w_up': nrm(ks[8], (DEPTH, 2, D, F), D ** -0.5),
        'ffn_w_down': nrm(ks[9], (DEPTH, 2, F, D), F ** -0.5),
        'ab_w_in': nrm(ks[10], (N_EVEN, D, AB_IN_DIM), D ** -0.5),
        'pool_w': nrm(ks[11], (N_EVEN, POOL_GROUPS, POOL_GROUP_DIM, POOL_GROUP_DIM), POOL_GROUP_DIM ** -0.5),
        'pool_scale': 1.0 + nrm(ks[12], (N_EVEN, POOL_DIM), 0.1),
        'q_norm_g': 1.0 + nrm(ks[13], (N_EVEN, Q_LORA_RANK), 0.02),
        'w_uq': nrm(ks[14], (N_EVEN, Q_LORA_RANK, MLA_HEADS * QK_HEAD_DIM), Q_LORA_RANK ** -0.5),
        'kv_norm_g': 1.0 + nrm(ks[15], (N_EVEN, KV_LORA_RANK), 0.02),
        'w_ukv': nrm(ks[16], (N_EVEN, KV_LORA_RANK, MLA_HEADS * (QK_NOPE_DIM + V_HEAD_DIM)), KV_LORA_RANK ** -0.5),
        'ab_w_out': nrm(ks[17], (N_EVEN, AB_OUT_DIM, D), AB_OUT_DIM ** -0.5),
        'conv_w_in': nrm(ks[18], (N_ODD, D, 3 * CONV_DIM), D ** -0.5),
        'conv_w': nrm(ks[19], (N_ODD, CONV_WIDTH, CONV_DIM), CONV_WIDTH ** -0.5),
        'conv_w_out': nrm(ks[20], (N_ODD, CONV_DIM, D), CONV_DIM ** -0.5),
        'final_norm_g': 1.0 + nrm(ks[21], (D,), 0.02),
    }


def reference(x, c, ctx, c_ctx, norm_g, w_mod, b_mod, ffn_w_gate, ffn_w_up, ffn_w_down,
              ab_w_in, pool_w, pool_scale, q_norm_g, w_uq, kv_norm_g, w_ukv, ab_w_out,
              conv_w_in, conv_w, conv_w_out, final_norm_g):
    tabs = axial_rope_tables(x.shape[1])
    h, g = x, ctx
    cond_g = c_ctx[None, :]
    for i in range(DEPTH):
        last = i == DEPTH - 1
        even = i % 2 == 0
        j = i // 2
        ctx_out = not last
        need_g = even or ctx_out
        m_h = modulation(c, w_mod[i], b_mod[i])
        h = ffn_half(h, m_h, 0, norm_g[i, 0], ffn_w_gate[i, 0], ffn_w_up[i, 0], ffn_w_down[i, 0])
        if need_g:
            m_g = modulation(cond_g, w_mod[i], b_mod[i])
            g = ffn_half(g, m_g, 0, norm_g[i, 0], ffn_w_gate[i, 0], ffn_w_up[i, 0], ffn_w_down[i, 0])
        uh, gate_h = adaln(h, norm_g[i, 1], m_h, 1)
        out_g = None
        if even:
            ug, gate_g = adaln(g, norm_g[i, 1], m_g, 1)
            out_h, out_g = pool_mla_mixer(uh, ug, tabs, ab_w_in[j], pool_w[j], pool_scale[j],
                                          q_norm_g[j], w_uq[j], kv_norm_g[j], w_ukv[j], ab_w_out[j], ctx_out)
        else:
            out_h = short_conv_mixer(uh, conv_w_in[j], conv_w[j], conv_w_out[j])
            if ctx_out:
                ug, gate_g = adaln(g, norm_g[i, 1], m_g, 1)
                out_g = short_conv_mixer(ug, conv_w_in[j], conv_w[j], conv_w_out[j])
        h = h + gate_h * out_h
        h = ffn_half(h, m_h, 2, norm_g[i, 2], ffn_w_gate[i, 1], ffn_w_up[i, 1], ffn_w_down[i, 1])
        if ctx_out:
            g = g + gate_g * out_g
            g = ffn_half(g, m_g, 2, norm_g[i, 2], ffn_w_gate[i, 1], ffn_w_up[i, 1], ffn_w_down[i, 1])
    return rmsnorm(h, final_norm_g)
```

```cpp
#include <hip/hip_runtime.h>
#include <hip/hip_cooperative_groups.h>
#include <cstdio>
#include <cstdint>
namespace cg = cooperative_groups;

#ifndef MK_PER_STEP
#define MK_PER_STEP 0
#endif

#define LAS __attribute__((address_space(3)))
typedef unsigned short bf16_t;
typedef short bf16x8 __attribute__((ext_vector_type(8)));
typedef float f32x4 __attribute__((ext_vector_type(4)));
typedef float f32x16 __attribute__((ext_vector_type(16)));
typedef unsigned u32x4 __attribute__((ext_vector_type(4)));
typedef unsigned u32x2 __attribute__((ext_vector_type(2)));

constexpr int DM = 1024, NB = 8, SEQ = 2048, CTXL = 256, FF = 2816;
constexpr int MH = NB * SEQ;
constexpr int MG = NB * CTXL;
constexpr int MALL = MH + MG;
constexpr int NIN = 1792;
constexpr int QW = 768;
constexpr float RMS_EPS = 1e-6f;
constexpr float QSCALE = 0.10206207261596577f * 1.4426950408889634f;

constexpr size_t MiB = 1u << 20;
constexpr size_t WS_MOD = 0;
constexpr size_t WS_ROPE = 1 * MiB;
constexpr size_t WS_RSQ = 1 * MiB + 256 * 1024;
constexpr size_t WS_RSKV = 1 * MiB + 384 * 1024;
constexpr size_t WS_BGU = 2 * MiB;
constexpr size_t WS_BD = 46 * MiB;
constexpr size_t WS_BIN = 68 * MiB;
constexpr size_t WS_BUQ = 72 * MiB;
constexpr size_t WS_BKV = 73 * MiB + 256 * 1024;
constexpr size_t WS_BPOOL = 74 * MiB;
constexpr size_t WS_BOUT = 75 * MiB;
constexpr size_t WS_BCIN = 77 * MiB;
constexpr size_t WS_BCOUT = 83 * MiB;
constexpr size_t WS_G = 85 * MiB;
constexpr size_t WS_U = 93 * MiB;
constexpr size_t WS_ACT = 129 * MiB;
constexpr size_t WS_T1 = 129 * MiB;
constexpr size_t WS_Q = 192 * MiB;
constexpr size_t WS_Z = 129 * MiB;
constexpr size_t WS_BGATE = 161 * MiB;
constexpr size_t WS_A2 = 193 * MiB;
constexpr size_t WS_K = 228 * MiB;
constexpr size_t WS_VT = 246 * MiB;
constexpr size_t WS_KR = 264 * MiB;
constexpr size_t WS_P = 266 * MiB;
constexpr size_t WS_END = 284 * MiB;

constexpr int LDS_BYTES = 147456;
constexpr int NSTEPS = 27;

__device__ __forceinline__ unsigned pk2(float lo, float hi) { unsigned r; asm("v_cvt_pk_bf16_f32 %0, %1, %2" : "=v"(r) : "v"(lo), "v"(hi)); return r; }
__device__ __forceinline__ float bflo(unsigned u) { return __uint_as_float(u << 16); }
__device__ __forceinline__ float bfhi(unsigned u) { return __uint_as_float(u & 0xffff0000u); }
__device__ __forceinline__ float silu_f(float x) { return x * __builtin_amdgcn_rcpf(1.0f + __builtin_amdgcn_exp2f(-1.4426950408889634f * x)); }
__device__ __forceinline__ float wave_sum(float v) {
#pragma unroll
    for (int o = 1; o < 64; o <<= 1) v += __shfl_xor(v, o);
    return v;
}
__device__ __forceinline__ int ropeperm(int j) { const int a = j >> 4, jj = j & 15; return 16 * a + ((jj < 8) ? 2 * jj : 2 * (jj - 8) + 1); }

namespace pg8 {
constexpr int BM = 256, BK = 64, HALF = 128, HTB = HALF * BK * 2, STAGE_BYTES = 8 * HTB, NXCD = 8, WGM = 8;
__host__ __device__ __forceinline__ int lds_byte(int r, int c) { const int st = (r >> 4) * 2 + (c >> 5), rr = r & 15, cc = c & 31, ob = rr * 64 + cc * 2; return st * 1024 + (ob ^ (((ob >> 9) & 1) << 5)); }
__host__ __device__ __forceinline__ void stage_rc(int b, int& R, int& C) { const int st = b / 1024, sb = b % 1024, swz = sb ^ (((sb >> 9) & 1) << 5); R = (st >> 1) * 16 + swz / 64; C = (st & 1) * 32 + (swz % 64) / 2; }
__host__ __device__ __forceinline__ int perm32(int rho) { const int n = rho >> 4, i = rho & 15; return 8 * (i >> 2) + 4 * n + (i & 3); }
struct Unit { int pm, pn; };
struct StaticOrder {
    int nM, nN, nwg, G, c;
    __device__ void init(int M, int N, int G_, int c_) { nM = M / BM; nN = N / BM; nwg = nM * nN; G = G_; c = c_; }
    __device__ bool next(int i, Unit& u) const {
        const long L = (long)i * G + c; if (L >= nwg) return false;
        int wgid = (int)L; { const int q = nwg / NXCD, r = nwg % NXCD, xcd = wgid % NXCD, off = wgid / NXCD; wgid = (xcd < r ? xcd * (q + 1) : r * (q + 1) + (xcd - r) * q) + off; }
        const int nig = WGM * nN, gid = wgid / nig, fm = gid * WGM, gsz = (nM - fm) < WGM ? (nM - fm) : WGM;
        u.pm = fm + ((wgid % nig) % gsz); u.pn = (wgid % nig) / gsz; return true;
    }
};

struct Epi {
    int mode;
    bf16_t* O; int ldc; bf16_t* O2;
    const float* rowscale; float rsmul; const float* colscale; const float* rope;
    const float* res_h; const float* res_g; float* out_h; float* out_g; const float* gate; float gs;
    __device__ __forceinline__ void operator()(const f32x4 (&acc)[2][2][4][2], const Unit& u, int wr, int wc, int fr, int fq) const {
        const int row0 = u.pm * BM + wr * 64 + fr;
        const int cw = wc * 32 + 8 * fq;
        if (mode == 3) {
            const bool isg = u.pm >= (MH / BM);
            const int cond = isg ? 8 : (u.pm >> 3);
            const float* res = isg ? (res_g - (size_t)MH * DM) : res_h;
            float* out = isg ? (out_g - (size_t)MH * DM) : out_h;
            const float* gt = gate + (size_t)cond * 9216 + u.pn * BM + cw;
            f32x4 gv[2][2];
#pragma unroll
            for (int bj = 0; bj < 2; ++bj)
#pragma unroll
                for (int n = 0; n < 2; ++n) gv[bj][n] = *(const f32x4*)(gt + bj * HALF + 4 * n) * gs;
#pragma unroll
            for (int ai = 0; ai < 2; ++ai)
#pragma unroll
                for (int m = 0; m < 4; ++m) {
                    const size_t off = (size_t)(row0 + ai * HALF + m * 16) * DM + u.pn * BM + cw;
#pragma unroll
                    for (int bj = 0; bj < 2; ++bj)
#pragma unroll
                        for (int n = 0; n < 2; ++n) {
                            const f32x4 r = *(const f32x4*)(res + off + bj * HALF + 4 * n);
                            *(f32x4*)(out + off + bj * HALF + 4 * n) = r + gv[bj][n] * acc[ai][bj][m][n];
                        }
                }
        } else if (mode == 1 || (mode == 2 && u.pn < 8)) {
            const bool sw = (mode == 1);
#pragma unroll
            for (int ai = 0; ai < 2; ++ai)
#pragma unroll
                for (int m = 0; m < 4; ++m) {
                    const f32x4 g0 = acc[ai][0][m][0], g1 = acc[ai][0][m][1], u0 = acc[ai][1][m][0], u1 = acc[ai][1][m][1];
                    f32x4 a0, a1;
                    if (sw) {
#pragma unroll
                        for (int i = 0; i < 4; ++i) { a0[i] = silu_f(g0[i]) * u0[i]; a1[i] = silu_f(g1[i]) * u1[i]; }
                    } else { a0 = g0 * u0; a1 = g1 * u1; }
                    u32x4 w; w.x = pk2(a0[0], a0[1]); w.y = pk2(a0[2], a0[3]); w.z = pk2(a1[0], a1[1]); w.w = pk2(a1[2], a1[3]);
                    *(u32x4*)(O + (size_t)(row0 + ai * HALF + m * 16) * ldc + u.pn * HALF + cw) = w;
                }
        } else if (mode == 2) {
#pragma unroll
            for (int ai = 0; ai < 2; ++ai)
#pragma unroll
                for (int m = 0; m < 4; ++m)
#pragma unroll
                    for (int bj = 0; bj < 2; ++bj) {
                        const f32x4 v0 = acc[ai][bj][m][0], v1 = acc[ai][bj][m][1];
                        u32x4 w; w.x = pk2(v0[0], v0[1]); w.y = pk2(v0[2], v0[3]); w.z = pk2(v1[0], v1[1]); w.w = pk2(v1[2], v1[3]);
                        *(u32x4*)(O2 + (size_t)(row0 + ai * HALF + m * 16) * DM + (u.pn - 8) * BM + bj * HALF + cw) = w;
                    }
        } else {
            f32x4 cs[2][2];
#pragma unroll
            for (int bj = 0; bj < 2; ++bj)
#pragma unroll
                for (int n = 0; n < 2; ++n) cs[bj][n] = colscale ? *(const f32x4*)(colscale + u.pn * BM + bj * HALF + cw + 4 * n) : (f32x4){1.f, 1.f, 1.f, 1.f};
#pragma unroll
            for (int ai = 0; ai < 2; ++ai)
#pragma unroll
                for (int m = 0; m < 4; ++m) {
                    const int row = row0 + ai * HALF + m * 16;
                    const float rs = rowscale ? rowscale[row] * rsmul : 1.0f;
#pragma unroll
                    for (int bj = 0; bj < 2; ++bj) {
                        const int col = u.pn * BM + bj * HALF + cw;
                        f32x4 v0 = acc[ai][bj][m][0] * cs[bj][0] * rs, v1 = acc[ai][bj][m][1] * cs[bj][1] * rs;
                        if (rope && row < MH && ((col >> 5) % 3) == 2) {
                            const float* tb = rope + (size_t)(row & (SEQ - 1)) * 32 + ((col & 31) >> 1);
                            const f32x4 cc = *(const f32x4*)tb, sn = *(const f32x4*)(tb + 16);
                            f32x4 w0, w1;
                            w0[0] = v0[0] * cc[0] - v0[1] * sn[0]; w0[1] = v0[1] * cc[0] + v0[0] * sn[0];
                            w0[2] = v0[2] * cc[1] - v0[3] * sn[1]; w0[3] = v0[3] * cc[1] + v0[2] * sn[1];
                            w1[0] = v1[0] * cc[2] - v1[1] * sn[2]; w1[1] = v1[1] * cc[2] + v1[0] * sn[2];
                            w1[2] = v1[2] * cc[3] - v1[3] * sn[3]; w1[3] = v1[3] * cc[3] + v1[2] * sn[3];
                            v0 = w0; v1 = w1;
                        }
                        u32x4 w; w.x = pk2(v0[0], v0[1]); w.y = pk2(v0[2], v0[3]); w.z = pk2(v1[0], v1[1]); w.w = pk2(v1[2], v1[3]);
                        *(u32x4*)(O + (size_t)row * ldc + col) = w;
                    }
                }
        }
    }
};

struct Gemm { const bf16_t* A; const bf16_t* Bt; int lda, ldb, M, N, K; };

__device__ __forceinline__ void gemm_phase(LAS unsigned char* lds, const Gemm g, const int G, const int cidx, const Epi& E, const int tid_op) {
    const int tid = tid_op, wid = __builtin_amdgcn_readfirstlane(tid >> 6), lane = tid & 63, wr = wid >> 2, wc = wid & 3, fr = lane & 15, fq = lane >> 4;
    const int K = g.K, nt = K / BK;
    StaticOrder S; S.init(g.M, g.N, G, cidx);
    unsigned voffA[2], voffB[2];
#pragma unroll
    for (int i = 0; i < 2; ++i) { int R, C; stage_rc(tid * 16 + i * 8192, R, C); const int Rb = (R & ~31) + perm32(R & 31);
        voffA[i] = (unsigned)(R * g.lda + C) * 2u; voffB[i] = (unsigned)(Rb * g.ldb + C) * 2u; }
    const size_t kstep = (size_t)(BK * 2);
    const size_t hstepA = (size_t)HALF * g.lda * 2, hstepB = (size_t)HALF * g.ldb * 2;
    const size_t tstepA = 2 * hstepA, tstepB = 2 * hstepB;
    const unsigned ldsw = (unsigned)wid * 1024u;
    const int aoff = lds_byte(wr * 64 + fr, fq * 8), boff = lds_byte(wc * 32 + fr, fq * 8);
#define PG8_SA(b, h) (((b) * 2 + (h)) * HTB)
#define PG8_SB(b, h) ((4 + (b) * 2 + (h)) * HTB)
#define PG8_STAGE(bufoff, gbase, voff) do { _Pragma("unroll") for (int _i = 0; _i < 2; ++_i) \
        __builtin_amdgcn_global_load_lds((const unsigned*)((const char*)(gbase) + (voff)[_i]), (LAS unsigned*)(lds + (bufoff) + ldsw + _i * 8192), 16, 0, 0); } while (0)
#define PG8_LDA(dst, b, h) do { _Pragma("unroll") for (int m = 0; m < 4; ++m) _Pragma("unroll") for (int k = 0; k < 2; ++k) dst[m][k] = *(const LAS bf16x8*)(lds + PG8_SA(b, h) + aoff + m * 2048 + k * 1024); } while (0)
#define PG8_LDB(dst, b, h) do { _Pragma("unroll") for (int n = 0; n < 2; ++n) _Pragma("unroll") for (int k = 0; k < 2; ++k) dst[n][k] = *(const LAS bf16x8*)(lds + PG8_SB(b, h) + boff + n * 2048 + k * 1024); } while (0)
#define PG8_MMA(ai, bj, At, Bt) do { __builtin_amdgcn_s_setprio(1); _Pragma("unroll") for (int m = 0; m < 4; ++m) _Pragma("unroll") for (int n = 0; n < 2; ++n) _Pragma("unroll") for (int k = 0; k < 2; ++k) \
        acc[ai][bj][m][n] = __builtin_amdgcn_mfma_f32_16x16x32_bf16(Bt[n][k], At[m][k], acc[ai][bj][m][n], 0, 0, 0); __builtin_amdgcn_s_setprio(0); } while (0)
#define PG8_WAIT_V(n) asm volatile("s_waitcnt vmcnt(" #n ")" ::: "memory")
#define PG8_WAIT_L(n) asm volatile("s_waitcnt lgkmcnt(" #n ")" ::: "memory")
#define PG8_BAR __builtin_amdgcn_s_barrier()
#define PG8_SCHED __builtin_amdgcn_sched_barrier(0)
    Unit cur, nxt; int ui = 0;
    if (!S.next(0, cur)) return;
    f32x4 acc[2][2][4][2];
#pragma unroll
    for (int a = 0; a < 2; ++a)
#pragma unroll
        for (int b = 0; b < 2; ++b)
#pragma unroll
            for (int m = 0; m < 4; ++m)
#pragma unroll
                for (int n = 0; n < 2; ++n) acc[a][b][m][n] = (f32x4){0.f, 0.f, 0.f, 0.f};
    bf16x8 At[4][2], B0[2][2], B1[2][2];
    const char* cA = (const char*)g.A + (size_t)cur.pm * tstepA; const char* cB = (const char*)g.Bt + (size_t)cur.pn * tstepB;
    PG8_STAGE(PG8_SB(0, 0), cB, voffB); PG8_STAGE(PG8_SB(0, 1), cB + hstepB, voffB); PG8_STAGE(PG8_SA(0, 0), cA, voffA); PG8_STAGE(PG8_SA(0, 1), cA + hstepA, voffA);
    if (wr == 1) PG8_BAR;
    PG8_WAIT_V(2); PG8_BAR;
    PG8_STAGE(PG8_SB(1, 0), cB + kstep, voffB); PG8_STAGE(PG8_SA(1, 0), cA + kstep, voffA); PG8_STAGE(PG8_SB(1, 1), cB + hstepB + kstep, voffB);
    PG8_WAIT_V(6); PG8_BAR;
    for (;;) {
        const bool has_next = S.next(ui + 1, nxt);
        const char* nA = has_next ? (const char*)g.A + (size_t)nxt.pm * tstepA : cA; const char* nB = has_next ? (const char*)g.Bt + (size_t)nxt.pn * tstepB : cB;
        for (int t = 0; t < nt; t += 2) {
            const bool last = (t == nt - 2);
            const char* a1 = cA + (size_t)(t + 1) * kstep;
            const char* a2 = last ? nA : cA + (size_t)(t + 2) * kstep; const char* b2 = last ? nB : cB + (size_t)(t + 2) * kstep;
            const char* a3 = a2 + kstep; const char* b3 = b2 + kstep;
            PG8_LDB(B0, 0, 0); PG8_LDB(B1, 0, 1); PG8_SCHED; PG8_LDA(At, 0, 0); PG8_STAGE(PG8_SA(1, 1), a1 + hstepA, voffA);
            PG8_WAIT_V(8); PG8_WAIT_L(0); PG8_BAR; PG8_MMA(0, 0, At, B0); PG8_MMA(0, 1, At, B1); PG8_BAR; PG8_SCHED;
            PG8_LDA(At, 0, 1); PG8_STAGE(PG8_SB(0, 0), b2, voffB); PG8_STAGE(PG8_SB(0, 1), b2 + hstepB, voffB); PG8_STAGE(PG8_SA(0, 0), a2, voffA);
            PG8_WAIT_V(8); PG8_WAIT_L(0); PG8_BAR; PG8_MMA(1, 0, At, B0); PG8_MMA(1, 1, At, B1); PG8_BAR; PG8_SCHED;
            PG8_LDB(B0, 1, 0); PG8_LDB(B1, 1, 1); PG8_SCHED; PG8_LDA(At, 1, 0); PG8_STAGE(PG8_SA(0, 1), a2 + hstepA, voffA);
            PG8_WAIT_V(8); PG8_WAIT_L(0); PG8_BAR; PG8_MMA(0, 0, At, B0); PG8_MMA(0, 1, At, B1); PG8_BAR; PG8_SCHED;
            PG8_LDA(At, 1, 1); PG8_STAGE(PG8_SB(1, 0), b3, voffB); PG8_STAGE(PG8_SB(1, 1), b3 + hstepB, voffB); PG8_STAGE(PG8_SA(1, 0), a3, voffA);
            PG8_WAIT_V(8); PG8_WAIT_L(0); PG8_BAR; PG8_MMA(1, 0, At, B0); PG8_MMA(1, 1, At, B1); PG8_BAR; PG8_SCHED;
        }
        if (wr == 0) PG8_BAR;
        E(acc, cur, wr, wc, fr, fq);
        if (!has_next) break;
#pragma unroll
        for (int a = 0; a < 2; ++a)
#pragma unroll
            for (int b = 0; b < 2; ++b)
#pragma unroll
                for (int m = 0; m < 4; ++m)
#pragma unroll
                    for (int n = 0; n < 2; ++n) acc[a][b][m][n] = (f32x4){0.f, 0.f, 0.f, 0.f};
        cur = nxt; cA = nA; cB = nB; ++ui;
        if (wr == 1) PG8_BAR;
    }
    PG8_WAIT_V(0);
    PG8_BAR;
#undef PG8_SA
#undef PG8_SB
#undef PG8_STAGE
#undef PG8_LDA
#undef PG8_LDB
#undef PG8_MMA
#undef PG8_WAIT_V
#undef PG8_WAIT_L
#undef PG8_BAR
#undef PG8_SCHED
}
}

struct Args {
    const float* in[22];
    float* out; unsigned char* ws;
    int st_lo, st_hi;
};

__device__ __forceinline__ int rowmap(int kind, int n) {
    switch (kind) {
        case 1: return 256 * (n >> 7) + (n & 127);
        case 2: return 256 * (n >> 7) + 128 + (n & 127);
        case 3: return n < 1536 ? n : 1536 + ropeperm(n - 1536);
        case 4: { const int h = n / 96, d = n - h * 96; return d < 64 ? n : h * 96 + 64 + ropeperm(d - 64); }
        case 5: { const int h = n >> 7, e = n & 127; return e < 64 ? h * 64 + e : 512 + h * 64 + (e - 64); }
        case 6: { if (n < 1024) return 2048 + n; const int j = (n - 1024) & 1023; return 256 * (j >> 7) + (n < 2048 ? 0 : 128) + (j & 127); }
        default: return n;
    }
}
__device__ __forceinline__ void conv_item(const float* W, int K, int N, bf16_t* WT, int kind, const float* kscale, LAS float* scr, int item, int lane) {
    const int nblk = N / 32, kb = item / nblk, nb = item - kb * nblk, k0 = 64 * kb, n0 = 32 * nb;
#pragma unroll 8
    for (int i = 0; i < 32; ++i) { const int kk = 2 * i + (lane >> 5); float v = W[(size_t)(k0 + kk) * N + n0 + (lane & 31)]; if (kscale) v *= kscale[k0 + kk]; scr[kk * 33 + (lane & 31)] = v; }
    asm volatile("s_waitcnt lgkmcnt(0)" ::: "memory");
    const int c = lane & 7;
#pragma unroll
    for (int j = 0; j < 4; ++j) { const int n = (lane >> 3) + 8 * j; const LAS float* s = scr + (8 * c) * 33 + n;
        u32x4 o; o.x = pk2(s[0 * 33], s[1 * 33]); o.y = pk2(s[2 * 33], s[3 * 33]); o.z = pk2(s[4 * 33], s[5 * 33]); o.w = pk2(s[6 * 33], s[7 * 33]);
        *(u32x4*)(WT + (size_t)rowmap(kind, n0 + n) * K + k0 + 8 * c) = o; }
    asm volatile("s_waitcnt lgkmcnt(0)" ::: "memory");
}

#define INP(i) (a.in[(i) + zero])
__device__ __forceinline__ void prologue_step(const Args& a, LAS unsigned char* lds, int G, int zero, const int tid_op) {
    const int tid = tid_op, lane = tid & 63, wave = tid >> 6;
    unsigned char* ws = a.ws + zero;
    {
        LAS float* sm = (LAS float*)lds;
        LAS float* red = (LAS float*)(lds + 40960);
        const float* c = INP(1); const float* cctx = INP(3);
        for (int e = tid; e < 9216; e += 512) { const int cond = e >> 10, k = e & 1023; const float x = cond < 8 ? c[cond * 1024 + k] : cctx[k]; sm[e] = x / (1.0f + __expf(-x)); }
        __syncthreads();
        float* MOD = (float*)(ws + WS_MOD);
        for (int unit = blockIdx.x; unit < 288; unit += G) {
            const int layer = unit / 144, n0 = (unit % 144) * 64;
            const float* W = INP(5) + (size_t)layer * 1024 * 9216 + n0 + lane;
            float acc[9];
#pragma unroll
            for (int q = 0; q < 9; ++q) acc[q] = 0.f;
            const int k0 = wave * 128;
#pragma unroll 8
            for (int kk = 0; kk < 128; ++kk) { const float w = W[(size_t)(k0 + kk) * 9216];
#pragma unroll
                for (int q = 0; q < 9; ++q) acc[q] += sm[q * 1024 + k0 + kk] * w; }
#pragma unroll
            for (int q = 0; q < 9; ++q) red[(wave * 9 + q) * 64 + lane] = acc[q];
            __syncthreads();
            for (int e = tid; e < 576; e += 512) { const int cond = e >> 6, l = e & 63; float s = 0.f;
#pragma unroll
                for (int w = 0; w < 8; ++w) s += red[(w * 9 + cond) * 64 + l];
                MOD[(size_t)layer * 82944 + cond * 9216 + n0 + l] = s + INP(6)[layer * 9216 + n0 + l]; }
            __syncthreads();
        }
    }
    const int gw = blockIdx.x * 8 + wave, NGW = G * 8;
    LAS float* scr = (LAS float*)(lds + wave * 16384);
    constexpr int I_F = 16 * 88;
    constexpr int I_IN = 16 * 49, I_UQ = 12 * 24, I_KV = 4 * 32, I_OUT = 16 * 32, I_CIN = 16 * 96;
    constexpr int NITEMS = 12 * I_F + I_IN + I_UQ + I_KV + I_OUT + I_CIN + I_OUT;
    for (int it = gw; it < NITEMS; it += NGW) {
        int r = it;
        if (r < 12 * I_F) { const int mat = r / I_F, item = r - mat * I_F, ls = mat / 3, which = mat - ls * 3;
            if (which == 0) conv_item(INP(7) + (size_t)ls * DM * FF, DM, FF, (bf16_t*)(ws + WS_BGU) + (size_t)ls * 5632 * 1024, 1, nullptr, scr, item, lane);
            else if (which == 1) conv_item(INP(8) + (size_t)ls * DM * FF, DM, FF, (bf16_t*)(ws + WS_BGU) + (size_t)ls * 5632 * 1024, 2, nullptr, scr, item, lane);
            else conv_item(INP(9) + (size_t)ls * FF * DM, FF, DM, (bf16_t*)(ws + WS_BD) + (size_t)ls * 1024 * 2816, 0, nullptr, scr, item, lane);
            continue; }
        r -= 12 * I_F;
        if (r < I_IN) { conv_item(INP(10), DM, 1568, (bf16_t*)(ws + WS_BIN), 3, nullptr, scr, r, lane); continue; } r -= I_IN;
        if (r < I_UQ) { conv_item(INP(14), 768, 768, (bf16_t*)(ws + WS_BUQ), 4, INP(13), scr, r, lane); continue; } r -= I_UQ;
        if (r < I_KV) { conv_item(INP(16), 256, 1024, (bf16_t*)(ws + WS_BKV), 5, INP(15), scr, r, lane); continue; } r -= I_KV;
        if (r < I_OUT) { conv_item(INP(17), DM, DM, (bf16_t*)(ws + WS_BOUT), 0, nullptr, scr, r, lane); continue; } r -= I_OUT;
        if (r < I_CIN) { conv_item(INP(18), DM, 3072, (bf16_t*)(ws + WS_BCIN), 6, nullptr, scr, r, lane); continue; } r -= I_CIN;
        conv_item(INP(20), DM, DM, (bf16_t*)(ws + WS_BCOUT), 0, nullptr, scr, r, lane);
    }
    const int gt = blockIdx.x * 512 + tid, NGT = G * 512;
    {
        unsigned* z = (unsigned*)((bf16_t*)(ws + WS_BIN) + (size_t)1568 * 1024);
        for (int e = gt; e < 224 * 512; e += NGT) z[e] = 0u;
    }
    {
        bf16_t* bp = (bf16_t*)(ws + WS_BPOOL); const float* pw = INP(11); const float* ps = INP(12);
        for (int e = gt; e < 512 * 256; e += NGT) { const int n = e >> 8, k = (e & 255) * 2, g = n >> 7, d = n & 127;
            float v0 = 0.f, v1 = 0.f;
            if ((k >> 7) == g) { v0 = pw[(size_t)g * 16384 + (k & 127) * 128 + d] * ps[n]; v1 = pw[(size_t)g * 16384 + ((k + 1) & 127) * 128 + d] * ps[n]; }
            ((unsigned*)bp)[e] = pk2(v0, v1); }
    }
    {
        float* rt = (float*)(ws + WS_ROPE);
        for (int e = gt; e < 2048 * 16; e += NGT) { const int t = e >> 4, p = e & 15, i = p & 7; const float pos = (p >> 3) ? (float)(t & 63) : (float)(t >> 6);
            const float freq = __builtin_amdgcn_exp2f(-(float)i * (13.287712379549449f / 8.0f)); const float ang = pos * freq;
            rt[t * 32 + p] = __cosf(ang); rt[t * 32 + 16 + p] = __sinf(ang); }
    }
}

__device__ __forceinline__ void norm_step(const float* src_h, const float* src_g, int M, const float* gain, const float* mod, int k, bf16_t* U, int G, const int tid_op) {
    const int lane = tid_op & 63, gw = blockIdx.x * 8 + (tid_op >> 6), NGW = G * 8;
    for (int grp = gw; grp < M / 8; grp += NGW) {
        const int r0 = grp * 8, cond = r0 < MH ? (r0 >> 11) : 8;
        const float* md = mod + (size_t)cond * 9216 + 3 * k * 1024;
        f32x4 gs[4], sh[4];
#pragma unroll
        for (int j = 0; j < 4; ++j) { const int c = 4 * lane + 256 * j; const f32x4 g = *(const f32x4*)(gain + c), sc = *(const f32x4*)(md + 1024 + c); sh[j] = *(const f32x4*)(md + c); gs[j] = g * (sc + 1.0f); }
#pragma unroll 2
        for (int i = 0; i < 8; ++i) {
            const int r = r0 + i;
            const float* src = r < MH ? src_h + (size_t)r * DM : src_g + (size_t)(r - MH) * DM;
            f32x4 v[4]; float ss = 0.f;
#pragma unroll
            for (int j = 0; j < 4; ++j) { v[j] = *(const f32x4*)(src + 4 * lane + 256 * j); ss += (v[j].x * v[j].x + v[j].y * v[j].y) + (v[j].z * v[j].z + v[j].w * v[j].w); }
            const float rstd = 1.0f / sqrtf(wave_sum(ss) * (1.0f / DM) + RMS_EPS);
#pragma unroll
            for (int j = 0; j < 4; ++j) { const f32x4 o = v[j] * rstd * gs[j] + sh[j]; u32x2 w; w.x = pk2(o.x, o.y); w.y = pk2(o.z, o.w);
                *(u32x2*)(U + (size_t)r * DM + 4 * lane + 256 * j) = w; }
        }
    }
}
__device__ __forceinline__ void final_norm_step(float* h, const float* gain, int G, const int tid_op) {
    const int lane = tid_op & 63, gw = blockIdx.x * 8 + (tid_op >> 6), NGW = G * 8;
    f32x4 gs[4];
#pragma unroll
    for (int j = 0; j < 4; ++j) gs[j] = *(const f32x4*)(gain + 4 * lane + 256 * j);
    for (int r = gw; r < MH; r += NGW) {
        float* src = h + (size_t)r * DM;
        f32x4 v[4]; float ss = 0.f;
#pragma unroll
        for (int j = 0; j < 4; ++j) { v[j] = *(const f32x4*)(src + 4 * lane + 256 * j); ss += (v[j].x * v[j].x + v[j].y * v[j].y) + (v[j].z * v[j].z + v[j].w * v[j].w); }
        const float rstd = 1.0f / sqrtf(wave_sum(ss) * (1.0f / DM) + RMS_EPS);
#pragma unroll
        for (int j = 0; j < 4; ++j) *(f32x4*)(src + 4 * lane + 256 * j) = v[j] * rstd * gs[j];
    }
}

__device__ __forceinline__ void prep_step(const bf16_t* T1, float* rsq, float* rskv, bf16_t* KR, bf16_t* P, const float* rope, int G, const int tid_op) {
    const int lane = tid_op & 63, gw = blockIdx.x * 8 + (tid_op >> 6), NGW = G * 8;
    for (int r = gw; r < MALL; r += NGW) {
        const bf16_t* row = T1 + (size_t)r * NIN;
        float sq = 0.f;
#pragma unroll
        for (int j = 0; j < 3; ++j) { const u32x2 w = *(const u32x2*)(row + 512 + 4 * lane + 256 * j); const float a = bflo(w.x), b = bfhi(w.x), c = bflo(w.y), d = bfhi(w.y); sq += (a * a + b * b) + (c * c + d * d); }
        float skv; { const u32x2 w = *(const u32x2*)(row + 1280 + 4 * lane); const float a = bflo(w.x), b = bfhi(w.x), c = bflo(w.y), d = bfhi(w.y); skv = (a * a + b * b) + (c * c + d * d); }
        sq = wave_sum(sq); skv = wave_sum(skv);
        if (lane == 0) { rsq[r] = 1.0f / sqrtf(sq * (1.0f / 768.0f) + RMS_EPS); rskv[r] = 1.0f / sqrtf(skv * (1.0f / 256.0f) + RMS_EPS); }
        if (lane < 16) {
            const unsigned w = *(const unsigned*)(row + 1536 + 2 * lane); float x = bflo(w), y = bfhi(w);
            if (r < MH) { const int t = r & (SEQ - 1); const float cc = rope[t * 32 + lane], sn = rope[t * 32 + 16 + lane]; const float nx = x * cc - y * sn, ny = y * cc + x * sn; x = nx; y = ny; }
            *(unsigned*)(KR + (size_t)r * 32 + 2 * lane) = pk2(x, y);
        }
        {
            int L, t; if (r < MH) { L = SEQ; t = r & (SEQ - 1); } else { L = CTXL; t = (r - MH) & (CTXL - 1); }
            const int w = 2 << (lane >> 4), lo = max(t - (w >> 1), 0), hi = min(t + (w - (w >> 1) - 1), L - 1);
            const bf16_t* base = T1 + (size_t)(r - t) * NIN + 8 * lane;
            float s[8];
#pragma unroll
            for (int i = 0; i < 8; ++i) s[i] = 0.f;
            for (int j = 0; j < 16; ++j) { const int tt = lo + j;
                if (tt <= hi) { const u32x4 v = *(const u32x4*)(base + (size_t)tt * NIN);
                    s[0] += bflo(v.x); s[1] += bfhi(v.x); s[2] += bflo(v.y); s[3] += bfhi(v.y); s[4] += bflo(v.z); s[5] += bfhi(v.z); s[6] += bflo(v.w); s[7] += bfhi(v.w); } }
            const float inv = 1.0f / (float)(hi - lo + 1);
            const u32x4 me = *(const u32x4*)(base + (size_t)t * NIN);
            u32x4 o;
            o.x = pk2(s[0] * inv - bflo(me.x), s[1] * inv - bfhi(me.x)); o.y = pk2(s[2] * inv - bflo(me.y), s[3] * inv - bfhi(me.y));
            o.z = pk2(s[4] * inv - bflo(me.z), s[5] * inv - bfhi(me.z)); o.w = pk2(s[6] * inv - bflo(me.w), s[7] * inv - bfhi(me.w));
            *(u32x4*)(P + (size_t)r * 512 + 8 * lane) = o;
        }
    }
}

__device__ __forceinline__ void convew_step(const bf16_t* Z, const bf16_t* BG, const float* cw, bf16_t* A2, int G, const int tid_op) {
    const int gt = blockIdx.x * 512 + tid_op, NGT = G * 512;
    for (int e = gt; e < MH * 128; e += NGT) {
        const int r = e >> 7, c0 = (e & 127) * 8, t = r & (SEQ - 1);
        const u32x4 z1 = *(const u32x4*)(Z + (size_t)r * DM + c0);
        u32x4 z0 = (u32x4){0u, 0u, 0u, 0u}, z2 = (u32x4){0u, 0u, 0u, 0u};
        if (t > 0) z0 = *(const u32x4*)(Z + (size_t)(r - 1) * DM + c0);
        if (t < SEQ - 1) z2 = *(const u32x4*)(Z + (size_t)(r + 1) * DM + c0);
        const u32x4 bg = *(const u32x4*)(BG + (size_t)r * DM + c0);
        const f32x4 w0a = *(const f32x4*)(cw + c0), w0b = *(const f32x4*)(cw + c0 + 4), w1a = *(const f32x4*)(cw + DM + c0), w1b = *(const f32x4*)(cw + DM + c0 + 4), w2a = *(const f32x4*)(cw + 2 * DM + c0), w2b = *(const f32x4*)(cw + 2 * DM + c0 + 4);
        float y[8];
        y[0] = bflo(bg.x) * (w0a[0] * bflo(z0.x) + w1a[0] * bflo(z1.x) + w2a[0] * bflo(z2.x));
        y[1] = bfhi(bg.x) * (w0a[1] * bfhi(z0.x) + w1a[1] * bfhi(z1.x) + w2a[1] * bfhi(z2.x));
        y[2] = bflo(bg.y) * (w0a[2] * bflo(z0.y) + w1a[2] * bflo(z1.y) + w2a[2] * bflo(z2.y));
        y[3] = bfhi(bg.y) * (w0a[3] * bfhi(z0.y) + w1a[3] * bfhi(z1.y) + w2a[3] * bfhi(z2.y));
        y[4] = bflo(bg.z) * (w0b[0] * bflo(z0.z) + w1b[0] * bflo(z1.z) + w2b[0] * bflo(z2.z));
        y[5] = bfhi(bg.z) * (w0b[1] * bfhi(z0.z) + w1b[1] * bfhi(z1.z) + w2b[1] * bfhi(z2.z));
        y[6] = bflo(bg.w) * (w0b[2] * bflo(z0.w) + w1b[2] * bflo(z1.w) + w2b[2] * bflo(z2.w));
        y[7] = bfhi(bg.w) * (w0b[3] * bfhi(z0.w) + w1b[3] * bfhi(z1.w) + w2b[3] * bfhi(z2.w));
        u32x4 o; o.x = pk2(y[0], y[1]); o.y = pk2(y[2], y[3]); o.z = pk2(y[4], y[5]); o.w = pk2(y[6], y[7]);
        *(u32x4*)(A2 + (size_t)r * DM + c0) = o;
    }
}

__device__ __forceinline__ void attn_step(LAS unsigned char* lds, const bf16_t* Q, const bf16_t* Kn, const bf16_t* KR, const bf16_t* Vt, bf16_t* CAT, int vcu, int G, const int tid_op) {
    const int tid = tid_op, lane = tid & 63, wave = tid >> 6, r32 = lane & 31, hi = lane >> 5;
    constexpr int KSTR = 208, VSTR = 136, KBUF = 64 * KSTR, VBUF = 64 * VSTR, BUF = KBUF + VBUF;
    const int kn_row = tid >> 3, kn_ch = tid & 7, kr_row = (tid & 255) >> 2, kr_ch = tid & 3;
    for (int u = vcu; u < 576; u += G) {
        int b, h, qrow0, nlat;
        if (u < 512) { b = u >> 6; h = (u >> 3) & 7; qrow0 = b * SEQ + (u & 7) * 256; nlat = 32; }
        else { const int uu = u - 512; b = uu >> 3; h = uu & 7; qrow0 = MH + b * CTXL; nlat = 0; }
        const int ntile = nlat + 4;
        const int qrow = qrow0 + wave * 32 + r32;
        bf16x8 qf[6];
#pragma unroll
        for (int ds = 0; ds < 6; ++ds) qf[ds] = *(const bf16x8*)(Q + (size_t)qrow * QW + h * 96 + ds * 16 + hi * 8);
        f32x16 o0, o1;
#pragma unroll
        for (int i = 0; i < 16; ++i) { o0[i] = 0.f; o1[i] = 0.f; }
        float mrow = -1e30f, lrow = 0.f;
        u32x4 gk, gr, gv;
#define ATT_LOAD(t) do { const int row0_ = ((t) < nlat) ? (b * SEQ + (t) * 64) : (MH + b * CTXL + ((t) - nlat) * 64); \
            gk = *(const u32x4*)(Kn + (size_t)(row0_ + kn_row) * 512 + h * 64 + kn_ch * 8); \
            gr = (u32x4){0u, 0u, 0u, 0u}; if (tid < 256) gr = *(const u32x4*)(KR + (size_t)(row0_ + kr_row) * 32 + kr_ch * 8); \
            gv = *(const u32x4*)(Vt + (size_t)(h * 64 + kn_row) * MALL + row0_ + kn_ch * 8); } while (0)
#define ATT_STORE(bufi) do { LAS unsigned char* kb_ = lds + (bufi) * BUF; LAS unsigned char* vb_ = kb_ + KBUF; \
            *(LAS u32x4*)(kb_ + kn_row * KSTR + kn_ch * 16) = gk; \
            if (tid < 256) *(LAS u32x4*)(kb_ + kr_row * KSTR + 128 + kr_ch * 16) = gr; \
            *(LAS u32x2*)(vb_ + kn_row * VSTR + kn_ch * 16) = (u32x2){gv.x, gv.y}; *(LAS u32x2*)(vb_ + kn_row * VSTR + kn_ch * 16 + 8) = (u32x2){gv.z, gv.w}; } while (0)
        ATT_LOAD(0);
        ATT_STORE(0);
        __syncthreads();
        for (int t = 0; t < ntile; ++t) {
            const bool more = (t + 1 < ntile);
            if (more) ATT_LOAD(t + 1);
            const LAS unsigned char* kb = lds + (t & 1) * BUF; const LAS unsigned char* vb = kb + KBUF;
            f32x16 p0, p1;
#pragma unroll
            for (int i = 0; i < 16; ++i) { p0[i] = 0.f; p1[i] = 0.f; }
#pragma unroll
            for (int ds = 0; ds < 6; ++ds) {
                const bf16x8 a0 = *(const LAS bf16x8*)(kb + r32 * KSTR + ds * 32 + hi * 16);
                const bf16x8 a1 = *(const LAS bf16x8*)(kb + (32 + r32) * KSTR + ds * 32 + hi * 16);
                p0 = __builtin_amdgcn_mfma_f32_32x32x16_bf16(a0, qf[ds], p0, 0, 0, 0);
                p1 = __builtin_amdgcn_mfma_f32_32x32x16_bf16(a1, qf[ds], p1, 0, 0, 0);
            }
            float mx = fmaxf(p0[0], p1[0]);
#pragma unroll
            for (int i = 1; i < 16; ++i) mx = fmaxf(mx, fmaxf(p0[i], p1[i]));
            mx = fmaxf(mx, __shfl_xor(mx, 32));
            const float mnew = fmaxf(mrow, mx), alpha = __builtin_amdgcn_exp2f(mrow - mnew);
            mrow = mnew;
            float ps = 0.f;
#pragma unroll
            for (int i = 0; i < 16; ++i) { p0[i] = __builtin_amdgcn_exp2f(p0[i] - mnew); p1[i] = __builtin_amdgcn_exp2f(p1[i] - mnew); ps += p0[i] + p1[i]; }
            lrow = lrow * alpha + ps;
#pragma unroll
            for (int i = 0; i < 16; ++i) { o0[i] *= alpha; o1[i] *= alpha; }
#pragma unroll
            for (int s = 0; s < 4; ++s) {
                u32x4 pw;
                if (s == 0) { pw.x = pk2(p0[0], p0[1]); pw.y = pk2(p0[2], p0[3]); pw.z = pk2(p0[4], p0[5]); pw.w = pk2(p0[6], p0[7]); }
                else if (s == 1) { pw.x = pk2(p0[8], p0[9]); pw.y = pk2(p0[10], p0[11]); pw.z = pk2(p0[12], p0[13]); pw.w = pk2(p0[14], p0[15]); }
                else if (s == 2) { pw.x = pk2(p1[0], p1[1]); pw.y = pk2(p1[2], p1[3]); pw.z = pk2(p1[4], p1[5]); pw.w = pk2(p1[6], p1[7]); }
                else { pw.x = pk2(p1[8], p1[9]); pw.y = pk2(p1[10], p1[11]); pw.z = pk2(p1[12], p1[13]); pw.w = pk2(p1[14], p1[15]); }
                const bf16x8 pb = __builtin_bit_cast(bf16x8, pw);
                const LAS unsigned char* vp = vb + r32 * VSTR + (16 * s + 4 * hi) * 2;
                const u32x2 l0 = *(const LAS u32x2*)vp, h0 = *(const LAS u32x2*)(vp + 16);
                const u32x2 l1 = *(const LAS u32x2*)(vp + 32 * VSTR), h1 = *(const LAS u32x2*)(vp + 32 * VSTR + 16);
                const bf16x8 va0 = __builtin_bit_cast(bf16x8, (u32x4){l0.x, l0.y, h0.x, h0.y});
                const bf16x8 va1 = __builtin_bit_cast(bf16x8, (u32x4){l1.x, l1.y, h1.x, h1.y});
                o0 = __builtin_amdgcn_mfma_f32_32x32x16_bf16(va0, pb, o0, 0, 0, 0);
                o1 = __builtin_amdgcn_mfma_f32_32x32x16_bf16(va1, pb, o1, 0, 0, 0);
            }
            if (more) ATT_STORE((t + 1) & 1);
            __syncthreads();
        }
#undef ATT_LOAD
#undef ATT_STORE
        const float ltot = lrow + __shfl_xor(lrow, 32);
        const float inv = 1.0f / ltot;
        bf16_t* orow = CAT + (size_t)qrow * DM + 512 + h * 64 + 4 * hi;
#pragma unroll
        for (int g = 0; g < 4; ++g) {
            u32x2 w0; w0.x = pk2(o0[4 * g] * inv, o0[4 * g + 1] * inv); w0.y = pk2(o0[4 * g + 2] * inv, o0[4 * g + 3] * inv);
            u32x2 w1; w1.x = pk2(o1[4 * g] * inv, o1[4 * g + 1] * inv); w1.y = pk2(o1[4 * g + 2] * inv, o1[4 * g + 3] * inv);
            *(u32x2*)(orow + 8 * g) = w0; *(u32x2*)(orow + 32 + 8 * g) = w1;
        }
    }
}

__global__ void __launch_bounds__(512, 2) mega_fwd(Args a) {
    extern __shared__ __attribute__((aligned(16))) unsigned char lds_raw[];
    LAS unsigned char* lds = (LAS unsigned char*)lds_raw;
    cg::grid_group grid = cg::this_grid();
    const int G = gridDim.x, bx = blockIdx.x;
    const int vcu = (G % 8 == 0) ? (bx % 8) * (G / 8) + bx / 8 : bx;

    for (int st = a.st_lo; st < a.st_hi; ++st) {
        int zero = 0; asm volatile("" : "+s"(zero));
        int tid_op = threadIdx.x; asm volatile("" : "+v"(tid_op));
        unsigned char* ws = a.ws + zero;
        float* MOD = (float*)(ws + WS_MOD);
        float* ROPE = (float*)(ws + WS_ROPE);
        float* RSQ = (float*)(ws + WS_RSQ);
        float* RSKV = (float*)(ws + WS_RSKV);
        bf16_t* U = (bf16_t*)(ws + WS_U);
        bf16_t* ACT = (bf16_t*)(ws + WS_ACT);
        bf16_t* T1 = (bf16_t*)(ws + WS_T1);
        float* Gs = (float*)(ws + WS_G);
        float* H = a.out + zero;
        int kind = 0;
        bool sync_after = true;
        pg8::Gemm g{}; pg8::Epi E{};
        int rot = 0;
        switch (st) {
            case 0: prologue_step(a, lds, G, zero, tid_op); break;
            case 1: norm_step(INP(0), INP(2), MALL, INP(4) + 0 * DM, MOD, 0, U, G, tid_op); break;
            case 13: norm_step(H, Gs, MALL, INP(4) + 2 * DM, MOD, 2, U, G, tid_op); break;
            case 4: norm_step(H, Gs, MALL, INP(4) + 1 * DM, MOD, 1, U, G, tid_op); break;
            case 2: case 14: case 17: case 24: {
                const int ls = (st == 2) ? 0 : (st == 14) ? 1 : (st == 17) ? 2 : 3;
                kind = 1; g = pg8::Gemm{U, (const bf16_t*)(ws + WS_BGU) + (size_t)ls * 5632 * 1024, DM, DM, ls < 2 ? MALL : MH, 2 * FF, DM};
                E.mode = 1; E.O = ACT; E.ldc = FF; break; }
            case 3: case 15: case 18: case 25: {
                const int ls = (st == 3) ? 0 : (st == 15) ? 1 : (st == 18) ? 2 : 3;
                kind = 1; g = pg8::Gemm{ACT, (const bf16_t*)(ws + WS_BD) + (size_t)ls * 1024 * 2816, FF, FF, ls < 2 ? MALL : MH, DM, FF};
                E.mode = 3; E.res_h = (st == 3) ? INP(0) : H; E.res_g = (st == 3) ? INP(2) : Gs; E.out_h = H; E.out_g = Gs;
                E.gate = MOD + (size_t)(ls >> 1) * 82944 + ((ls & 1) ? 8 : 2) * 1024; E.gs = 0.5f; break; }
            case 5: kind = 1; g = pg8::Gemm{U, (const bf16_t*)(ws + WS_BIN), DM, DM, MALL, NIN, DM}; E.mode = 0; E.O = T1; E.ldc = NIN; break;
            case 6: prep_step(T1, RSQ, RSKV, (bf16_t*)(ws + WS_KR), (bf16_t*)(ws + WS_P), ROPE, G, tid_op); break;
            case 7: kind = 1; sync_after = false; g = pg8::Gemm{T1 + 512, (const bf16_t*)(ws + WS_BUQ), NIN, QW, MALL, QW, QW};
                E.mode = 0; E.O = (bf16_t*)(ws + WS_Q); E.ldc = QW; E.rowscale = RSQ; E.rsmul = QSCALE; E.rope = ROPE; break;
            case 8: kind = 1; sync_after = false; rot = 40; g = pg8::Gemm{T1 + 1280, (const bf16_t*)(ws + WS_BKV), NIN, 256, MALL, 512, 256};
                E.mode = 0; E.O = (bf16_t*)(ws + WS_K); E.ldc = 512; E.rowscale = RSKV; E.rsmul = 1.0f; break;
            case 9: kind = 1; sync_after = false; rot = 152; g = pg8::Gemm{(const bf16_t*)(ws + WS_BKV) + (size_t)512 * 256, T1 + 1280, 256, NIN, 512, MALL, 256};
                E.mode = 0; E.O = (bf16_t*)(ws + WS_VT); E.ldc = MALL; E.colscale = RSKV; break;
            case 10: kind = 1; rot = 8; g = pg8::Gemm{(const bf16_t*)(ws + WS_P), (const bf16_t*)(ws + WS_BPOOL), 512, 512, MALL, 512, 512};
                E.mode = 0; E.O = U; E.ldc = DM; break;
            case 11: attn_step(lds, (const bf16_t*)(ws + WS_Q), (const bf16_t*)(ws + WS_K), (const bf16_t*)(ws + WS_KR), (const bf16_t*)(ws + WS_VT), U, vcu, G, tid_op); break;
            case 12: kind = 1; g = pg8::Gemm{U, (const bf16_t*)(ws + WS_BOUT), DM, DM, MALL, DM, DM};
                E.mode = 3; E.res_h = H; E.res_g = Gs; E.out_h = H; E.out_g = Gs; E.gate = MOD + 5 * 1024; E.gs = 1.0f; break;
            case 16: norm_step(H, Gs, MH, INP(4) + 3 * DM, MOD + 82944, 0, U, G, tid_op); break;
            case 19: norm_step(H, Gs, MH, INP(4) + 4 * DM, MOD + 82944, 1, U, G, tid_op); break;
            case 23: norm_step(H, Gs, MH, INP(4) + 5 * DM, MOD + 82944, 2, U, G, tid_op); break;
            case 20: kind = 1; g = pg8::Gemm{U, (const bf16_t*)(ws + WS_BCIN), DM, DM, MH, 3072, DM}; E.mode = 2; E.O = (bf16_t*)(ws + WS_Z); E.ldc = DM; E.O2 = (bf16_t*)(ws + WS_BGATE); break;
            case 21: convew_step((const bf16_t*)(ws + WS_Z), (const bf16_t*)(ws + WS_BGATE), INP(19), (bf16_t*)(ws + WS_A2), G, tid_op); break;
            case 22: kind = 1; g = pg8::Gemm{(const bf16_t*)(ws + WS_A2), (const bf16_t*)(ws + WS_BCOUT), DM, DM, MH, DM, DM};
                E.mode = 3; E.res_h = H; E.res_g = Gs; E.out_h = H; E.out_g = Gs; E.gate = MOD + 82944 + 5 * 1024; E.gs = 1.0f; break;
            case 26: final_norm_step(H, INP(21), G, tid_op); sync_after = false; break;
            default: break;
        }
        if (kind == 1) { const int c = (bx + rot) % G; pg8::gemm_phase(lds, g, G, c, E, tid_op); }
        if (sync_after && st + 1 < a.st_hi) grid.sync();
    }
}

extern "C" void kernel_launch(void* const* d_in, const int* in_sizes, int n_in, void* d_out, int out_size, void* d_ws, size_t ws_size, hipStream_t stream) {
    static int grid = 0;
    if (grid == 0) {
        if (n_in != 22 || ws_size < WS_END) { fprintf(stderr, "kernel_launch: unexpected n_in %d / ws_size %zu\n", n_in, ws_size); grid = -1; return; }
        int dev = 0, cus = 0, per_cu = 0;
        hipGetDevice(&dev);
        hipDeviceGetAttribute(&cus, hipDeviceAttributeMultiprocessorCount, dev);
        hipFuncSetAttribute((const void*)mega_fwd, hipFuncAttributeMaxDynamicSharedMemorySize, LDS_BYTES);
        hipOccupancyMaxActiveBlocksPerMultiprocessor(&per_cu, (const void*)mega_fwd, 512, LDS_BYTES);
        if (per_cu < 1) { fprintf(stderr, "kernel_launch: occupancy query says %d blocks per CU\n", per_cu); per_cu = 1; }
        (void)hipGetLastError();
        grid = cus;
    }
    if (grid < 0) return;
    Args a{};
    for (int i = 0; i < 22; ++i) a.in[i] = (const float*)d_in[i];
    a.out = (float*)d_out; a.ws = (unsigned char*)d_ws;
#if MK_PER_STEP
    for (int s = 0; s < NSTEPS; ++s) {
        a.st_lo = s; a.st_hi = s + 1;
        hipLaunchKernelGGL(mega_fwd, dim3(grid), dim3(512), LDS_BYTES, stream, a);
    }
#else
    a.st_lo = 0; a.st_hi = NSTEPS;
    void* args[] = {&a};
    hipError_t e = hipLaunchCooperativeKernel((const void*)mega_fwd, dim3(grid), dim3(512), args, LDS_BYTES, stream);
    if (e != hipSuccess) fprintf(stderr, "cooperative launch failed: %s (grid %d)\n", hipGetErrorString(e), grid);
#endif
}
```

```cpp
#include <hip/hip_runtime.h>
#include <hip/hip_cooperative_groups.h>
#include <cstdio>
#include <cstdint>
namespace cg = cooperative_groups;

#ifndef MK_REPEAT_MASK
#define MK_REPEAT_MASK 0u
#endif
#ifndef MK_PER_STEP
#define MK_PER_STEP 0
#endif

#define LAS __attribute__((address_space(3)))
typedef unsigned short bf16_t;
typedef short bf16x8 __attribute__((ext_vector_type(8)));
typedef float f32x4 __attribute__((ext_vector_type(4)));
typedef float f32x16 __attribute__((ext_vector_type(16)));
typedef unsigned u32x4 __attribute__((ext_vector_type(4)));
typedef unsigned u32x2 __attribute__((ext_vector_type(2)));

constexpr int DM = 1024, NB = 8, SEQ = 2048, CTXL = 256, FF = 2816;
constexpr int MH = NB * SEQ;
constexpr int MG = NB * CTXL;
constexpr int MALL = MH + MG;
constexpr int NIN = 1792;
constexpr int QW = 768;
constexpr float RMS_EPS = 1e-6f;
constexpr float QSCALE = 0.10206207261596577f * 1.4426950408889634f;

constexpr size_t MiB = 1u << 20;
constexpr size_t WS_MOD = 0;
constexpr size_t WS_ROPE = 1 * MiB;
constexpr size_t WS_RSQ = 1 * MiB + 256 * 1024;
constexpr size_t WS_RSKV = 1 * MiB + 384 * 1024;
constexpr size_t WS_BAR = 1 * MiB + 512 * 1024;
constexpr size_t WS_BGU = 2 * MiB;
constexpr size_t WS_BD = 46 * MiB;
constexpr size_t WS_BIN = 68 * MiB;
constexpr size_t WS_BUQ = 72 * MiB;
constexpr size_t WS_BKV = 73 * MiB + 256 * 1024;
constexpr size_t WS_BPOOL = 74 * MiB;
constexpr size_t WS_BOUT = 75 * MiB;
constexpr size_t WS_BCIN = 77 * MiB;
constexpr size_t WS_BCOUT = 83 * MiB;
constexpr size_t WS_G = 85 * MiB;
constexpr size_t WS_U = 93 * MiB;
constexpr size_t WS_ACT = 129 * MiB;
constexpr size_t WS_T1 = 129 * MiB;
constexpr size_t WS_Q = 192 * MiB;
constexpr size_t WS_Z = 129 * MiB;
constexpr size_t WS_BGATE = 161 * MiB;
constexpr size_t WS_A2 = 193 * MiB;
constexpr size_t WS_K = 228 * MiB;
constexpr size_t WS_VT = 246 * MiB;
constexpr size_t WS_KR = 264 * MiB;
constexpr size_t WS_P = 266 * MiB;
constexpr size_t WS_PART = 228 * MiB;
constexpr size_t WS_END = 292 * MiB;

constexpr int LDS_BYTES = 147456;
constexpr int NSTEPS = 27;

__device__ __forceinline__ unsigned pk2(float lo, float hi) { unsigned r; asm("v_cvt_pk_bf16_f32 %0, %1, %2" : "=v"(r) : "v"(lo), "v"(hi)); return r; }
__device__ __forceinline__ float bflo(unsigned u) { return __uint_as_float(u << 16); }
__device__ __forceinline__ float bfhi(unsigned u) { return __uint_as_float(u & 0xffff0000u); }
__device__ __forceinline__ float silu_f(float x) { return x * __builtin_amdgcn_rcpf(1.0f + __builtin_amdgcn_exp2f(-1.4426950408889634f * x)); }
__device__ __forceinline__ float wave_sum(float v) {
#pragma unroll
    for (int o = 1; o < 64; o <<= 1) v += __shfl_xor(v, o);
    return v;
}
__device__ __forceinline__ int ropeperm(int j) { const int a = j >> 4, jj = j & 15; return 16 * a + ((jj < 8) ? 2 * jj : 2 * (jj - 8) + 1); }

namespace pg8 {
constexpr int BM = 256, BK = 64, HALF = 128, HTB = HALF * BK * 2, STAGE_BYTES = 8 * HTB, NXCD = 8, WGM = 8;
__host__ __device__ __forceinline__ int lds_byte(int r, int c) { const int st = (r >> 4) * 2 + (c >> 5), rr = r & 15, cc = c & 31, ob = rr * 64 + cc * 2; return st * 1024 + (ob ^ (((ob >> 9) & 1) << 5)); }
__host__ __device__ __forceinline__ void stage_rc(int b, int& R, int& C) { const int st = b / 1024, sb = b % 1024, swz = sb ^ (((sb >> 9) & 1) << 5); R = (st >> 1) * 16 + swz / 64; C = (st & 1) * 32 + (swz % 64) / 2; }
__host__ __device__ __forceinline__ int perm32(int rho) { const int n = rho >> 4, i = rho & 15; return 8 * (i >> 2) + 4 * n + (i & 3); }
struct Unit { int pm, pn, kt0, nkt, sl; bool partial; };
struct StaticOrder {
    int nM, nN, nwg, G, c, nt, nT, S, tpm0;
    __device__ void init(int M, int N, int K, int G_, int c_, int tail_pm0, int tail_npm) { nM = M / BM; nN = N / BM; nwg = nM * nN; G = G_; c = c_; nt = K / BK;
        nT = tail_npm * nN; tpm0 = tail_pm0; S = 0; if (nT > 0) { S = (G % nT == 0) ? (G / nT) : 1; if (S > nt / 2) S = nt / 2; if (S > 8) S = 8; } }
    __device__ void map(int L, Unit& u) const {
        int wgid = L; { const int q = nwg / NXCD, r = nwg % NXCD, xcd = wgid % NXCD, off = wgid / NXCD; wgid = (xcd < r ? xcd * (q + 1) : r * (q + 1) + (xcd - r) * q) + off; }
        const int nig = WGM * nN, gid = wgid / nig, fm = gid * WGM, gsz = (nM - fm) < WGM ? (nM - fm) : WGM;
        u.pm = fm + ((wgid % nig) % gsz); u.pn = (wgid % nig) / gsz;
    }
    __device__ bool next(int i, Unit& u) const {
        const long L = (long)i * G + c;
        if (L < nwg) { map((int)L, u); u.kt0 = 0; u.nkt = nt; u.sl = 0; u.partial = false; return true; }
        const long Lt = L - nwg; if (Lt >= (long)nT * S) return false;
        const int tu = (int)Lt / S, sl = (int)Lt - tu * S, nt2 = nt / 2, p0 = (sl * nt2) / S, p1 = ((sl + 1) * nt2) / S;
        u.pm = tpm0 + tu / nN; u.pn = tu % nN; u.kt0 = 2 * p0; u.nkt = 2 * (p1 - p0); u.sl = sl; u.partial = true; return true;
    }
};

struct Epi {
    int mode;
    int ldc; float f0, f1;
    void* p0; const void* p1; const void* p2; const void* p3;
    __device__ __forceinline__ void operator()(const f32x4 (&acc)[2][2][4][2], const Unit& u, int wr, int wc, int fr, int fq) const {
        const int row0 = u.pm * BM + wr * 64 + fr;
        const int cw = wc * 32 + 8 * fq;
        if (u.partial) {
            float* pp = (float*)p2 + ((size_t)u.sl * MG + (size_t)(row0 - MH)) * DM + u.pn * BM + cw;
#pragma unroll
            for (int ai = 0; ai < 2; ++ai)
#pragma unroll
                for (int m = 0; m < 4; ++m)
#pragma unroll
                    for (int bj = 0; bj < 2; ++bj)
#pragma unroll
                        for (int n = 0; n < 2; ++n) *(f32x4*)(pp + (size_t)(ai * HALF + m * 16) * DM + bj * HALF + 4 * n) = acc[ai][bj][m][n];
        } else if (mode == 3) {
            const int cond = u.pm >> 3;
            float* out = (float*)p0; const float* res = out; const float gs = f0;
            const float* gt = (const float*)p1 + (size_t)cond * 9216 + u.pn * BM + cw;
            f32x4 gv[2][2];
#pragma unroll
            for (int bj = 0; bj < 2; ++bj)
#pragma unroll
                for (int n = 0; n < 2; ++n) gv[bj][n] = *(const f32x4*)(gt + bj * HALF + 4 * n) * gs;
#pragma unroll
            for (int ai = 0; ai < 2; ++ai)
#pragma unroll
                for (int m = 0; m < 4; ++m) {
                    const size_t off = (size_t)(row0 + ai * HALF + m * 16) * DM + u.pn * BM + cw;
#pragma unroll
                    for (int bj = 0; bj < 2; ++bj)
#pragma unroll
                        for (int n = 0; n < 2; ++n) {
                            const f32x4 r = *(const f32x4*)(res + off + bj * HALF + 4 * n);
                            *(f32x4*)(out + off + bj * HALF + 4 * n) = r + gv[bj][n] * acc[ai][bj][m][n];
                        }
                }
        } else if (mode == 1 || (mode == 2 && u.pn < 8)) {
            const bool sw = (mode == 1);
#pragma unroll
            for (int ai = 0; ai < 2; ++ai)
#pragma unroll
                for (int m = 0; m < 4; ++m) {
                    const f32x4 g0 = acc[ai][0][m][0], g1 = acc[ai][0][m][1], u0 = acc[ai][1][m][0], u1 = acc[ai][1][m][1];
                    f32x4 a0, a1;
                    if (sw) {
#pragma unroll
                        for (int i = 0; i < 4; ++i) { a0[i] = silu_f(g0[i]) * u0[i]; a1[i] = silu_f(g1[i]) * u1[i]; }
                    } else { a0 = g0 * u0; a1 = g1 * u1; }
                    u32x4 w; w.x = pk2(a0[0], a0[1]); w.y = pk2(a0[2], a0[3]); w.z = pk2(a1[0], a1[1]); w.w = pk2(a1[2], a1[3]);
                    *(u32x4*)((bf16_t*)p0 + (size_t)(row0 + ai * HALF + m * 16) * ldc + u.pn * HALF + cw) = w;
                }
        } else if (mode == 2) {
#pragma unroll
            for (int ai = 0; ai < 2; ++ai)
#pragma unroll
                for (int m = 0; m < 4; ++m)
#pragma unroll
                    for (int bj = 0; bj < 2; ++bj) {
                        const f32x4 v0 = acc[ai][bj][m][0], v1 = acc[ai][bj][m][1];
                        u32x4 w; w.x = pk2(v0[0], v0[1]); w.y = pk2(v0[2], v0[3]); w.z = pk2(v1[0], v1[1]); w.w = pk2(v1[2], v1[3]);
                        *(u32x4*)((bf16_t*)p1 + (size_t)(row0 + ai * HALF + m * 16) * DM + (u.pn - 8) * BM + bj * HALF + cw) = w;
                    }
        } else {
            const float* rowscale = (const float*)p1; const float* colscale = (const float*)p2; const float* rope = (const float*)p3; const float rsmul = f0;
            f32x4 cs[2][2];
#pragma unroll
            for (int bj = 0; bj < 2; ++bj)
#pragma unroll
                for (int n = 0; n < 2; ++n) cs[bj][n] = colscale ? *(const f32x4*)(colscale + u.pn * BM + bj * HALF + cw + 4 * n) : (f32x4){1.f, 1.f, 1.f, 1.f};
#pragma unroll
            for (int ai = 0; ai < 2; ++ai)
#pragma unroll
                for (int m = 0; m < 4; ++m) {
                    const int row = row0 + ai * HALF + m * 16;
                    const float rs = rowscale ? rowscale[row] * rsmul : 1.0f;
#pragma unroll
                    for (int bj = 0; bj < 2; ++bj) {
                        const int col = u.pn * BM + bj * HALF + cw;
                        f32x4 v0 = acc[ai][bj][m][0] * cs[bj][0] * rs, v1 = acc[ai][bj][m][1] * cs[bj][1] * rs;
                        if (rope && row < MH && ((col >> 5) % 3) == 2) {
                            const float* tb = rope + (size_t)(row & (SEQ - 1)) * 32 + ((col & 31) >> 1);
                            const f32x4 cc = *(const f32x4*)tb, sn = *(const f32x4*)(tb + 16);
                            f32x4 w0, w1;
                            w0[0] = v0[0] * cc[0] - v0[1] * sn[0]; w0[1] = v0[1] * cc[0] + v0[0] * sn[0];
                            w0[2] = v0[2] * cc[1] - v0[3] * sn[1]; w0[3] = v0[3] * cc[1] + v0[2] * sn[1];
                            w1[0] = v1[0] * cc[2] - v1[1] * sn[2]; w1[1] = v1[1] * cc[2] + v1[0] * sn[2];
                            w1[2] = v1[2] * cc[3] - v1[3] * sn[3]; w1[3] = v1[3] * cc[3] + v1[2] * sn[3];
                            v0 = w0; v1 = w1;
                        }
                        u32x4 w; w.x = pk2(v0[0], v0[1]); w.y = pk2(v0[2], v0[3]); w.z = pk2(v1[0], v1[1]); w.w = pk2(v1[2], v1[3]);
                        *(u32x4*)((bf16_t*)p0 + (size_t)row * ldc + col) = w;
                    }
                }
        }
    }
};

struct Gemm { const bf16_t* A; const bf16_t* Bt; int lda, ldb, M, N, K, tail_pm0, tail_npm; };

__device__ __forceinline__ void gemm_phase(LAS unsigned char* lds, const Gemm g, const int G, const int cidx, const Epi& E, const int tid_op) {
    const int tid = tid_op, wid = __builtin_amdgcn_readfirstlane(tid >> 6), lane = tid & 63, wr = wid >> 2, wc = wid & 3, fr = lane & 15, fq = lane >> 4;
    StaticOrder S; S.init(g.M, g.N, g.K, G, cidx, g.tail_pm0, g.tail_npm);
    unsigned voffA[2], voffB[2];
#pragma unroll
    for (int i = 0; i < 2; ++i) { int R, C; stage_rc(tid * 16 + i * 8192, R, C); const int Rb = (R & ~31) + perm32(R & 31);
        voffA[i] = (unsigned)(R * g.lda + C) * 2u; voffB[i] = (unsigned)(Rb * g.ldb + C) * 2u; }
    const size_t kstep = (size_t)(BK * 2);
    const size_t hstepA = (size_t)HALF * g.lda * 2, hstepB = (size_t)HALF * g.ldb * 2;
    const size_t tstepA = 2 * hstepA, tstepB = 2 * hstepB;
    const unsigned ldsw = (unsigned)wid * 1024u;
    const int aoff = lds_byte(wr * 64 + fr, fq * 8), boff = lds_byte(wc * 32 + fr, fq * 8);
#define PG8_SA(b, h) (((b) * 2 + (h)) * HTB)
#define PG8_SB(b, h) ((4 + (b) * 2 + (h)) * HTB)
#define PG8_STAGE(bufoff, gbase, voff) do { _Pragma("unroll") for (int _i = 0; _i < 2; ++_i) \
        __builtin_amdgcn_global_load_lds((const unsigned*)((const char*)(gbase) + (voff)[_i]), (LAS unsigned*)(lds + (bufoff) + ldsw + _i * 8192), 16, 0, 0); } while (0)
#define PG8_LDA(dst, b, h) do { _Pragma("unroll") for (int m = 0; m < 4; ++m) _Pragma("unroll") for (int k = 0; k < 2; ++k) dst[m][k] = *(const LAS bf16x8*)(lds + PG8_SA(b, h) + aoff + m * 2048 + k * 1024); } while (0)
#define PG8_LDB(dst, b, h) do { _Pragma("unroll") for (int n = 0; n < 2; ++n) _Pragma("unroll") for (int k = 0; k < 2; ++k) dst[n][k] = *(const LAS bf16x8*)(lds + PG8_SB(b, h) + boff + n * 2048 + k * 1024); } while (0)
#define PG8_MMA(ai, bj, At, Bt) do { __builtin_amdgcn_s_setprio(1); _Pragma("unroll") for (int m = 0; m < 4; ++m) _Pragma("unroll") for (int n = 0; n < 2; ++n) _Pragma("unroll") for (int k = 0; k < 2; ++k) \
        acc[ai][bj][m][n] = __builtin_amdgcn_mfma_f32_16x16x32_bf16(Bt[n][k], At[m][k], acc[ai][bj][m][n], 0, 0, 0); __builtin_amdgcn_s_setprio(0); } while (0)
#define PG8_WAIT_V(n) asm volatile("s_waitcnt vmcnt(" #n ")" ::: "memory")
#define PG8_WAIT_L(n) asm volatile("s_waitcnt lgkmcnt(" #n ")" ::: "memory")
#define PG8_BAR __builtin_amdgcn_s_barrier()
#define PG8_SCHED __builtin_amdgcn_sched_barrier(0)
    Unit cur, nxt; int ui = 0;
    if (!S.next(0, cur)) return;
    f32x4 acc[2][2][4][2];
#pragma unroll
    for (int a = 0; a < 2; ++a)
#pragma unroll
        for (int b = 0; b < 2; ++b)
#pragma unroll
            for (int m = 0; m < 4; ++m)
#pragma unroll
                for (int n = 0; n < 2; ++n) acc[a][b][m][n] = (f32x4){0.f, 0.f, 0.f, 0.f};
    bf16x8 At[4][2], B0[2][2], B1[2][2];
    const char* cA = (const char*)g.A + (size_t)cur.pm * tstepA + (size_t)cur.kt0 * kstep; const char* cB = (const char*)g.Bt + (size_t)cur.pn * tstepB + (size_t)cur.kt0 * kstep;
    PG8_STAGE(PG8_SB(0, 0), cB, voffB); PG8_STAGE(PG8_SB(0, 1), cB + hstepB, voffB); PG8_STAGE(PG8_SA(0, 0), cA, voffA); PG8_STAGE(PG8_SA(0, 1), cA + hstepA, voffA);
    if (wr == 1) PG8_BAR;
    PG8_WAIT_V(2); PG8_BAR;
    PG8_STAGE(PG8_SB(1, 0), cB + kstep, voffB); PG8_STAGE(PG8_SA(1, 0), cA + kstep, voffA); PG8_STAGE(PG8_SB(1, 1), cB + hstepB + kstep, voffB);
    PG8_WAIT_V(6); PG8_BAR;
    for (;;) {
        const bool has_next = S.next(ui + 1, nxt);
        const char* nA = has_next ? (const char*)g.A + (size_t)nxt.pm * tstepA + (size_t)nxt.kt0 * kstep : cA; const char* nB = has_next ? (const char*)g.Bt + (size_t)nxt.pn * tstepB + (size_t)nxt.kt0 * kstep : cB;
        const int nt = cur.nkt;
        for (int t = 0; t < nt; t += 2) {
            const bool last = (t == nt - 2);
            const char* a1 = cA + (size_t)(t + 1) * kstep;
            const char* a2 = last ? nA : cA + (size_t)(t + 2) * kstep; const char* b2 = last ? nB : cB + (size_t)(t + 2) * kstep;
            const char* a3 = a2 + kstep; const char* b3 = b2 + kstep;
            PG8_LDB(B0, 0, 0); PG8_LDB(B1, 0, 1); PG8_SCHED; PG8_LDA(At, 0, 0); PG8_STAGE(PG8_SA(1, 1), a1 + hstepA, voffA);
            PG8_WAIT_V(8); PG8_WAIT_L(0); PG8_BAR; PG8_MMA(0, 0, At, B0); PG8_MMA(0, 1, At, B1); PG8_BAR; PG8_SCHED;
            PG8_LDA(At, 0, 1); PG8_STAGE(PG8_SB(0, 0), b2, voffB); PG8_STAGE(PG8_SB(0, 1), b2 + hstepB, voffB); PG8_STAGE(PG8_SA(0, 0), a2, voffA);
            PG8_WAIT_V(8); PG8_WAIT_L(0); PG8_BAR; PG8_MMA(1, 0, At, B0); PG8_MMA(1, 1, At, B1); PG8_BAR; PG8_SCHED;
            PG8_LDB(B0, 1, 0); PG8_LDB(B1, 1, 1); PG8_SCHED; PG8_LDA(At, 1, 0); PG8_STAGE(PG8_SA(0, 1), a2 + hstepA, voffA);
            PG8_WAIT_V(8); PG8_WAIT_L(0); PG8_BAR; PG8_MMA(0, 0, At, B0); PG8_MMA(0, 1, At, B1); PG8_BAR; PG8_SCHED;
            PG8_LDA(At, 1, 1); PG8_STAGE(PG8_SB(1, 0), b3, voffB); PG8_STAGE(PG8_SB(1, 1), b3 + hstepB, voffB); PG8_STAGE(PG8_SA(1, 0), a3, voffA);
            PG8_WAIT_V(8); PG8_WAIT_L(0); PG8_BAR; PG8_MMA(1, 0, At, B0); PG8_MMA(1, 1, At, B1); PG8_BAR; PG8_SCHED;
        }
        if (wr == 0) PG8_BAR;
        E(acc, cur, wr, wc, fr, fq);
        if (!has_next) break;
#pragma unroll
        for (int a = 0; a < 2; ++a)
#pragma unroll
            for (int b = 0; b < 2; ++b)
#pragma unroll
                for (int m = 0; m < 4; ++m)
#pragma unroll
                    for (int n = 0; n < 2; ++n) acc[a][b][m][n] = (f32x4){0.f, 0.f, 0.f, 0.f};
        cur = nxt; cA = nA; cB = nB; ++ui;
        if (wr == 1) PG8_BAR;
    }
    PG8_WAIT_V(0);
    PG8_BAR;
#undef PG8_SA
#undef PG8_SB
#undef PG8_STAGE
#undef PG8_LDA
#undef PG8_LDB
#undef PG8_MMA
#undef PG8_WAIT_V
#undef PG8_WAIT_L
#undef PG8_BAR
#undef PG8_SCHED
}
}

struct Args {
    const float* in[22];
    float* out; unsigned char* ws;
    int st_lo, st_hi;
};

__device__ __forceinline__ int rowmap(int kind, int n) {
    switch (kind) {
        case 1: return 256 * (n >> 7) + (n & 127);
        case 2: return 256 * (n >> 7) + 128 + (n & 127);
        case 3: return n < 1536 ? n : 1536 + ropeperm(n - 1536);
        case 4: { const int h = n / 96, d = n - h * 96; return d < 64 ? n : h * 96 + 64 + ropeperm(d - 64); }
        case 5: { const int h = n >> 7, e = n & 127; return e < 64 ? h * 64 + e : 512 + h * 64 + (e - 64); }
        case 6: { if (n < 1024) return 2048 + n; const int j = (n - 1024) & 1023; return 256 * (j >> 7) + (n < 2048 ? 0 : 128) + (j & 127); }
        default: return n;
    }
}
__device__ __forceinline__ void conv_item(const float* W, int K, int N, bf16_t* WT, int kind, const float* kscale, LAS float* scr, int item, int lane) {
    const int nblk = N / 32, kb = item / nblk, nb = item - kb * nblk, k0 = 64 * kb, n0 = 32 * nb;
#pragma unroll 8
    for (int i = 0; i < 32; ++i) { const int kk = 2 * i + (lane >> 5); float v = W[(size_t)(k0 + kk) * N + n0 + (lane & 31)]; if (kscale) v *= kscale[k0 + kk]; scr[kk * 33 + (lane & 31)] = v; }
    asm volatile("s_waitcnt lgkmcnt(0)" ::: "memory");
    const int c = lane & 7;
#pragma unroll
    for (int j = 0; j < 4; ++j) { const int n = (lane >> 3) + 8 * j; const LAS float* s = scr + (8 * c) * 33 + n;
        u32x4 o; o.x = pk2(s[0 * 33], s[1 * 33]); o.y = pk2(s[2 * 33], s[3 * 33]); o.z = pk2(s[4 * 33], s[5 * 33]); o.w = pk2(s[6 * 33], s[7 * 33]);
        *(u32x4*)(WT + (size_t)rowmap(kind, n0 + n) * K + k0 + 8 * c) = o; }
    asm volatile("s_waitcnt lgkmcnt(0)" ::: "memory");
}

#define INP(i) (a.in[(i) + zero])
__device__ __forceinline__ void prologue_step(const Args& a, LAS unsigned char* lds, int G, int zero, const int tid_op) {
    const int tid = tid_op, lane = tid & 63, wave = tid >> 6;
    unsigned char* ws = a.ws + zero;
    {
        LAS float* sm = (LAS float*)lds;
        LAS float* red = (LAS float*)(lds + 40960);
        const float* c = INP(1); const float* cctx = INP(3);
        for (int e = tid; e < 9216; e += 512) { const int cond = e >> 10, k = e & 1023; const float x = cond < 8 ? c[cond * 1024 + k] : cctx[k]; sm[e] = x / (1.0f + __expf(-x)); }
        __syncthreads();
        float* MOD = (float*)(ws + WS_MOD);
        for (int unit = blockIdx.x; unit < 288; unit += G) {
            const int layer = unit / 144, n0 = (unit % 144) * 64;
            const float* W = INP(5) + (size_t)layer * 1024 * 9216 + n0 + lane;
            float acc[9];
#pragma unroll
            for (int q = 0; q < 9; ++q) acc[q] = 0.f;
            const int k0 = wave * 128;
#pragma unroll 8
            for (int kk = 0; kk < 128; ++kk) { const float w = W[(size_t)(k0 + kk) * 9216];
#pragma unroll
                for (int q = 0; q < 9; ++q) acc[q] += sm[q * 1024 + k0 + kk] * w; }
#pragma unroll
            for (int q = 0; q < 9; ++q) red[(wave * 9 + q) * 64 + lane] = acc[q];
            __syncthreads();
            for (int e = tid; e < 576; e += 512) { const int cond = e >> 6, l = e & 63; float s = 0.f;
#pragma unroll
                for (int w = 0; w < 8; ++w) s += red[(w * 9 + cond) * 64 + l];
                MOD[(size_t)layer * 82944 + cond * 9216 + n0 + l] = s + INP(6)[layer * 9216 + n0 + l]; }
            __syncthreads();
        }
    }
    const int gw = blockIdx.x * 8 + wave, NGW = G * 8;
    LAS float* scr = (LAS float*)(lds + wave * 16384);
    constexpr int I_F = 16 * 88;
    constexpr int I_IN = 16 * 49, I_UQ = 12 * 24, I_KV = 4 * 32, I_OUT = 16 * 32, I_CIN = 16 * 96;
    constexpr int NITEMS = 12 * I_F + I_IN + I_UQ + I_KV + I_OUT + I_CIN + I_OUT;
    for (int it = gw; it < NITEMS; it += NGW) {
        int r = it;
        if (r < 12 * I_F) { const int mat = r / I_F, item = r - mat * I_F, ls = mat / 3, which = mat - ls * 3;
            if (which == 0) conv_item(INP(7) + (size_t)ls * DM * FF, DM, FF, (bf16_t*)(ws + WS_BGU) + (size_t)ls * 5632 * 1024, 1, nullptr, scr, item, lane);
            else if (which == 1) conv_item(INP(8) + (size_t)ls * DM * FF, DM, FF, (bf16_t*)(ws + WS_BGU) + (size_t)ls * 5632 * 1024, 2, nullptr, scr, item, lane);
            else conv_item(INP(9) + (size_t)ls * FF * DM, FF, DM, (bf16_t*)(ws + WS_BD) + (size_t)ls * 1024 * 2816, 0, nullptr, scr, item, lane);
            continue; }
        r -= 12 * I_F;
        if (r < I_IN) { conv_item(INP(10), DM, 1568, (bf16_t*)(ws + WS_BIN), 3, nullptr, scr, r, lane); continue; } r -= I_IN;
        if (r < I_UQ) { conv_item(INP(14), 768, 768, (bf16_t*)(ws + WS_BUQ), 4, INP(13), scr, r, lane); continue; } r -= I_UQ;
        if (r < I_KV) { conv_item(INP(16), 256, 1024, (bf16_t*)(ws + WS_BKV), 5, INP(15), scr, r, lane); continue; } r -= I_KV;
        if (r < I_OUT) { conv_item(INP(17), DM, DM, (bf16_t*)(ws + WS_BOUT), 0, nullptr, scr, r, lane); continue; } r -= I_OUT;
        if (r < I_CIN) { conv_item(INP(18), DM, 3072, (bf16_t*)(ws + WS_BCIN), 6, nullptr, scr, r, lane); continue; } r -= I_CIN;
        conv_item(INP(20), DM, DM, (bf16_t*)(ws + WS_BCOUT), 0, nullptr, scr, r, lane);
    }
    const int gt = blockIdx.x * 512 + tid, NGT = G * 512;
    {
        unsigned* z = (unsigned*)((bf16_t*)(ws + WS_BIN) + (size_t)1568 * 1024);
        for (int e = gt; e < 224 * 512; e += NGT) z[e] = 0u;
    }
    {
        bf16_t* bp = (bf16_t*)(ws + WS_BPOOL); const float* pw = INP(11); const float* ps = INP(12);
        for (int e = gt; e < 512 * 256; e += NGT) { const int n = e >> 8, k = (e & 255) * 2, g = n >> 7, d = n & 127;
            float v0 = 0.f, v1 = 0.f;
            if ((k >> 7) == g) { v0 = pw[(size_t)g * 16384 + (k & 127) * 128 + d] * ps[n]; v1 = pw[(size_t)g * 16384 + ((k + 1) & 127) * 128 + d] * ps[n]; }
            ((unsigned*)bp)[e] = pk2(v0, v1); }
    }
    {
        float* rt = (float*)(ws + WS_ROPE);
        for (int e = gt; e < 2048 * 16; e += NGT) { const int t = e >> 4, p = e & 15, i = p & 7; const float pos = (p >> 3) ? (float)(t & 63) : (float)(t >> 6);
            const float freq = __builtin_amdgcn_exp2f(-(float)i * (13.287712379549449f / 8.0f)); const float ang = pos * freq;
            rt[t * 32 + p] = __cosf(ang); rt[t * 32 + 16 + p] = __sinf(ang); }
    }
}

__device__ __forceinline__ void norm_step(const float* __restrict__ src_h, const float* __restrict__ src_g, int M, const float* __restrict__ gain, const float* __restrict__ mod, int k, bf16_t* __restrict__ U,
                                          float* __restrict__ cp_h, float* __restrict__ cp_g, const float* __restrict__ part, int part_S, const float* __restrict__ pgate, float pgs, int G, const int tid_op) {
    const int lane = tid_op & 63, gw = blockIdx.x * 8 + (tid_op >> 6), NGW = G * 8;
    const int nrows = (M == MALL) ? 9 : 8;
    for (int vw = gw; vw < MH / 8; vw += NGW) {
        int cur = -1; f32x4 gs[4], sh[4];
#pragma unroll
        for (int j = 0; j < 4; ++j) { gs[j] = (f32x4){0.f, 0.f, 0.f, 0.f}; sh[j] = gs[j]; }
        for (int ib = 0; ib < nrows; ib += 3) {
            f32x4 v[3][4];
#pragma unroll
            for (int i = 0; i < 3; ++i) { const int ii = min(ib + i, nrows - 1); const int r = ii < 8 ? 8 * vw + ii : MH + vw;
                const float* src = r < MH ? src_h + (size_t)r * DM : src_g + (size_t)(r - MH) * DM;
#pragma unroll
                for (int j = 0; j < 4; ++j) v[i][j] = *(const f32x4*)(src + 4 * lane + 256 * j); }
#pragma unroll
            for (int i = 0; i < 3; ++i) { const int ii = ib + i;
                if (ii < nrows) {
                    const int r = ii < 8 ? 8 * vw + ii : MH + vw;
                    const int cond = r < MH ? (r >> 11) : 8;
                    if (cond != cur) { cur = cond; const float* md = mod + (size_t)cond * 9216 + 3 * k * 1024;
#pragma unroll
                        for (int j = 0; j < 4; ++j) { const int c = 4 * lane + 256 * j; const f32x4 g = *(const f32x4*)(gain + c), sc = *(const f32x4*)(md + 1024 + c); sh[j] = *(const f32x4*)(md + c); gs[j] = g * (sc + 1.0f); } }
                    if (part && r >= MH) {
#pragma unroll
                        for (int j = 0; j < 4; ++j) { f32x4 ps = (f32x4){0.f, 0.f, 0.f, 0.f};
                            for (int sl = 0; sl < part_S; ++sl) ps += *(const f32x4*)(part + ((size_t)sl * MG + (r - MH)) * DM + 4 * lane + 256 * j);
                            v[i][j] += ps * (*(const f32x4*)(pgate + 4 * lane + 256 * j)) * pgs; } }
                    float ss = 0.f;
#pragma unroll
                    for (int j = 0; j < 4; ++j) ss += (v[i][j].x * v[i][j].x + v[i][j].y * v[i][j].y) + (v[i][j].z * v[i][j].z + v[i][j].w * v[i][j].w);
                    const float rstd = 1.0f / sqrtf(wave_sum(ss) * (1.0f / DM) + RMS_EPS);
                    if (cp_h) { float* dst = r < MH ? cp_h + (size_t)r * DM : cp_g + (size_t)(r - MH) * DM;
#pragma unroll
                        for (int j = 0; j < 4; ++j) *(f32x4*)(dst + 4 * lane + 256 * j) = v[i][j]; }
#pragma unroll
                    for (int j = 0; j < 4; ++j) { const f32x4 o = v[i][j] * rstd * gs[j] + sh[j]; u32x2 w; w.x = pk2(o.x, o.y); w.y = pk2(o.z, o.w);
                        *(u32x2*)(U + (size_t)r * DM + 4 * lane + 256 * j) = w; }
                }
            }
        }
    }
}
__device__ __forceinline__ void final_norm_step(float* h, const float* gain, int G, const int tid_op) {
    const int lane = tid_op & 63, gw = blockIdx.x * 8 + (tid_op >> 6), NGW = G * 8;
    f32x4 gs[4];
#pragma unroll
    for (int j = 0; j < 4; ++j) gs[j] = *(const f32x4*)(gain + 4 * lane + 256 * j);
    const int RPW = (MH + NGW - 1) / NGW, r0 = gw * RPW, r1 = min(r0 + RPW, MH);
    for (int rb = r0; rb < r1; rb += 4) {
        f32x4 v[4][4];
#pragma unroll
        for (int i = 0; i < 4; ++i) { const int r = min(rb + i, r1 - 1);
#pragma unroll
            for (int j = 0; j < 4; ++j) v[i][j] = *(const f32x4*)(h + (size_t)r * DM + 4 * lane + 256 * j); }
#pragma unroll
        for (int i = 0; i < 4; ++i) { const int r = rb + i;
            if (r < r1) { float ss = 0.f;
#pragma unroll
                for (int j = 0; j < 4; ++j) ss += (v[i][j].x * v[i][j].x + v[i][j].y * v[i][j].y) + (v[i][j].z * v[i][j].z + v[i][j].w * v[i][j].w);
                const float rstd = 1.0f / sqrtf(wave_sum(ss) * (1.0f / DM) + RMS_EPS);
#pragma unroll
                for (int j = 0; j < 4; ++j) *(f32x4*)(h + (size_t)r * DM + 4 * lane + 256 * j) = v[i][j] * rstd * gs[j]; } }
    }
}

__device__ __forceinline__ void prep_step(const bf16_t* __restrict__ T1, float* __restrict__ rsq, float* __restrict__ rskv, bf16_t* __restrict__ KR, bf16_t* __restrict__ P, const float* __restrict__ rope, int G, const int tid_op) {
    const int lane = tid_op & 63, gw = blockIdx.x * 8 + (tid_op >> 6), NGW = G * 8;
    const int w = 2 << (lane >> 4);
    for (int r = gw; r < MALL; r += NGW) {
        const bf16_t* row = T1 + (size_t)r * NIN;
        int L, t; if (r < MH) { L = SEQ; t = r & (SEQ - 1); } else { L = CTXL; t = (r - MH) & (CTXL - 1); }
        const int lo = max(t - (w >> 1), 0), hi = min(t + (w - (w >> 1) - 1), L - 1);
        const bf16_t* base = T1 + (size_t)(r - t) * NIN + 8 * lane;
        const bool lat = r < MH;
        u32x4 pv[16];
#pragma unroll
        for (int j = 0; j < 16; ++j) pv[j] = lat ? *(const u32x4*)(base + (size_t)min(lo + j, hi) * NIN) : (u32x4){0u, 0u, 0u, 0u};
        const u32x4 me = *(const u32x4*)(base + (size_t)t * NIN);
        u32x2 qv[3];
#pragma unroll
        for (int j = 0; j < 3; ++j) qv[j] = *(const u32x2*)(row + 512 + 4 * lane + 256 * j);
        const u32x2 kvv = *(const u32x2*)(row + 1280 + 4 * lane);
        const unsigned krw = *(const unsigned*)(row + 1536 + 2 * (lane & 15));
        float sq = 0.f;
#pragma unroll
        for (int j = 0; j < 3; ++j) { const float a = bflo(qv[j].x), b = bfhi(qv[j].x), c = bflo(qv[j].y), d = bfhi(qv[j].y); sq += (a * a + b * b) + (c * c + d * d); }
        float skv; { const float a = bflo(kvv.x), b = bfhi(kvv.x), c = bflo(kvv.y), d = bfhi(kvv.y); skv = (a * a + b * b) + (c * c + d * d); }
        sq = wave_sum(sq); skv = wave_sum(skv);
        if (lane == 0) { rsq[r] = 1.0f / sqrtf(sq * (1.0f / 768.0f) + RMS_EPS); rskv[r] = 1.0f / sqrtf(skv * (1.0f / 256.0f) + RMS_EPS); }
        if (lane < 16) {
            float x = bflo(krw), y = bfhi(krw);
            if (r < MH) { const int tt = r & (SEQ - 1); const float cc = rope[tt * 32 + lane], sn = rope[tt * 32 + 16 + lane]; const float nx = x * cc - y * sn, ny = y * cc + x * sn; x = nx; y = ny; }
            *(unsigned*)(KR + (size_t)r * 32 + 2 * lane) = pk2(x, y);
        }
        float s[8];
#pragma unroll
        for (int i = 0; i < 8; ++i) s[i] = 0.f;
#pragma unroll
        for (int j = 0; j < 16; ++j) { const float m = (lo + j <= hi) ? 1.0f : 0.0f; const u32x4 v = pv[j];
            s[0] += m * bflo(v.x); s[1] += m * bfhi(v.x); s[2] += m * bflo(v.y); s[3] += m * bfhi(v.y); s[4] += m * bflo(v.z); s[5] += m * bfhi(v.z); s[6] += m * bflo(v.w); s[7] += m * bfhi(v.w); }
        const float inv = 1.0f / (float)(hi - lo + 1);
        u32x4 o;
        o.x = pk2(s[0] * inv - bflo(me.x), s[1] * inv - bfhi(me.x)); o.y = pk2(s[2] * inv - bflo(me.y), s[3] * inv - bfhi(me.y));
        o.z = pk2(s[4] * inv - bflo(me.z), s[5] * inv - bfhi(me.z)); o.w = pk2(s[6] * inv - bflo(me.w), s[7] * inv - bfhi(me.w));
        if (lat) *(u32x4*)(P + (size_t)r * 512 + 8 * lane) = o;
    }
}

__device__ __forceinline__ void convew_step(const bf16_t* Z, const bf16_t* BG, const float* cw, bf16_t* A2, int G, const int tid_op) {
    const int gt = blockIdx.x * 512 + tid_op, NGT = G * 512;
    for (int e = gt; e < MH * 128; e += NGT) {
        const int r = e >> 7, c0 = (e & 127) * 8, t = r & (SEQ - 1);
        const u32x4 z1 = *(const u32x4*)(Z + (size_t)r * DM + c0);
        u32x4 z0 = (u32x4){0u, 0u, 0u, 0u}, z2 = (u32x4){0u, 0u, 0u, 0u};
        if (t > 0) z0 = *(const u32x4*)(Z + (size_t)(r - 1) * DM + c0);
        if (t < SEQ - 1) z2 = *(const u32x4*)(Z + (size_t)(r + 1) * DM + c0);
        const u32x4 bg = *(const u32x4*)(BG + (size_t)r * DM + c0);
        const f32x4 w0a = *(const f32x4*)(cw + c0), w0b = *(const f32x4*)(cw + c0 + 4), w1a = *(const f32x4*)(cw + DM + c0), w1b = *(const f32x4*)(cw + DM + c0 + 4), w2a = *(const f32x4*)(cw + 2 * DM + c0), w2b = *(const f32x4*)(cw + 2 * DM + c0 + 4);
        float y[8];
        y[0] = bflo(bg.x) * (w0a[0] * bflo(z0.x) + w1a[0] * bflo(z1.x) + w2a[0] * bflo(z2.x));
        y[1] = bfhi(bg.x) * (w0a[1] * bfhi(z0.x) + w1a[1] * bfhi(z1.x) + w2a[1] * bfhi(z2.x));
        y[2] = bflo(bg.y) * (w0a[2] * bflo(z0.y) + w1a[2] * bflo(z1.y) + w2a[2] * bflo(z2.y));
        y[3] = bfhi(bg.y) * (w0a[3] * bfhi(z0.y) + w1a[3] * bfhi(z1.y) + w2a[3] * bfhi(z2.y));
        y[4] = bflo(bg.z) * (w0b[0] * bflo(z0.z) + w1b[0] * bflo(z1.z) + w2b[0] * bflo(z2.z));
        y[5] = bfhi(bg.z) * (w0b[1] * bfhi(z0.z) + w1b[1] * bfhi(z1.z) + w2b[1] * bfhi(z2.z));
        y[6] = bflo(bg.w) * (w0b[2] * bflo(z0.w) + w1b[2] * bflo(z1.w) + w2b[2] * bflo(z2.w));
        y[7] = bfhi(bg.w) * (w0b[3] * bfhi(z0.w) + w1b[3] * bfhi(z1.w) + w2b[3] * bfhi(z2.w));
        u32x4 o; o.x = pk2(y[0], y[1]); o.y = pk2(y[2], y[3]); o.z = pk2(y[4], y[5]); o.w = pk2(y[6], y[7]);
        *(u32x4*)(A2 + (size_t)r * DM + c0) = o;
    }
}

__device__ __forceinline__ void attn_step(LAS unsigned char* lds, const bf16_t* Q, const bf16_t* Kn, const bf16_t* KR, const bf16_t* Vt, bf16_t* CAT, int vcu, int G, const int tid_op) {
    const int tid = tid_op, lane = tid & 63, wave = tid >> 6, r32 = lane & 31, hi = lane >> 5;
    constexpr int KSTR = 208, VSTR = 136, KBUF = 64 * KSTR, VBUF = 64 * VSTR, BUF = KBUF + VBUF;
    const int kn_row = tid >> 3, kn_ch = tid & 7, kr_row = (tid & 255) >> 2, kr_ch = tid & 3;
    for (int u = vcu; u < 512; u += G) {
        int b, h, qrow0, nlat;
        if (u < 512) { b = u >> 6; h = (u >> 3) & 7; qrow0 = b * SEQ + (u & 7) * 256; nlat = 32; }
        else { const int uu = u - 512; b = uu >> 3; h = uu & 7; qrow0 = MH + b * CTXL; nlat = 0; }
        const int ntile = nlat + 4;
        const int qrow = qrow0 + wave * 32 + r32;
        bf16x8 qf[6];
#pragma unroll
        for (int ds = 0; ds < 6; ++ds) qf[ds] = *(const bf16x8*)(Q + (size_t)qrow * QW + h * 96 + ds * 16 + hi * 8);
        f32x16 o0, o1;
#pragma unroll
        for (int i = 0; i < 16; ++i) { o0[i] = 0.f; o1[i] = 0.f; }
        float mrow = -1e30f, lrow = 0.f;
        u32x4 gk, gr, gv;
#define ATT_LOAD(t) do { const int row0_ = ((t) < nlat) ? (b * SEQ + (t) * 64) : (MH + b * CTXL + ((t) - nlat) * 64); \
            gk = *(const u32x4*)(Kn + (size_t)(row0_ + kn_row) * 512 + h * 64 + kn_ch * 8); \
            gr = (u32x4){0u, 0u, 0u, 0u}; if (tid < 256) gr = *(const u32x4*)(KR + (size_t)(row0_ + kr_row) * 32 + kr_ch * 8); \
            gv = *(const u32x4*)(Vt + (size_t)(h * 64 + kn_row) * MALL + row0_ + kn_ch * 8); } while (0)
#define ATT_STORE(bufi) do { LAS unsigned char* kb_ = lds + (bufi) * BUF; LAS unsigned char* vb_ = kb_ + KBUF; \
            *(LAS u32x4*)(kb_ + kn_row * KSTR + kn_ch * 16) = gk; \
            if (tid < 256) *(LAS u32x4*)(kb_ + kr_row * KSTR + 128 + kr_ch * 16) = gr; \
            *(LAS u32x2*)(vb_ + kn_row * VSTR + kn_ch * 16) = (u32x2){gv.x, gv.y}; *(LAS u32x2*)(vb_ + kn_row * VSTR + kn_ch * 16 + 8) = (u32x2){gv.z, gv.w}; } while (0)
        ATT_LOAD(0);
        ATT_STORE(0);
        __syncthreads();
        for (int t = 0; t < ntile; ++t) {
            const bool more = (t + 1 < ntile);
            if (more) ATT_LOAD(t + 1);
            const LAS unsigned char* kb = lds + (t & 1) * BUF; const LAS unsigned char* vb = kb + KBUF;
            f32x16 p0, p1;
#pragma unroll
            for (int i = 0; i < 16; ++i) { p0[i] = 0.f; p1[i] = 0.f; }
#pragma unroll
            for (int ds = 0; ds < 6; ++ds) {
                const bf16x8 a0 = *(const LAS bf16x8*)(kb + r32 * KSTR + ds * 32 + hi * 16);
                const bf16x8 a1 = *(const LAS bf16x8*)(kb + (32 + r32) * KSTR + ds * 32 + hi * 16);
                p0 = __builtin_amdgcn_mfma_f32_32x32x16_bf16(a0, qf[ds], p0, 0, 0, 0);
                p1 = __builtin_amdgcn_mfma_f32_32x32x16_bf16(a1, qf[ds], p1, 0, 0, 0);
            }
            float mx = fmaxf(p0[0], p1[0]);
#pragma unroll
            for (int i = 1; i < 16; ++i) mx = fmaxf(mx, fmaxf(p0[i], p1[i]));
            mx = fmaxf(mx, __shfl_xor(mx, 32));
            const float mnew = fmaxf(mrow, mx), alpha = __builtin_amdgcn_exp2f(mrow - mnew);
            mrow = mnew;
            float ps = 0.f;
#pragma unroll
            for (int i = 0; i < 16; ++i) { p0[i] = __builtin_amdgcn_exp2f(p0[i] - mnew); p1[i] = __builtin_amdgcn_exp2f(p1[i] - mnew); ps += p0[i] + p1[i]; }
            lrow = lrow * alpha + ps;
#pragma unroll
            for (int i = 0; i < 16; ++i) { o0[i] *= alpha; o1[i] *= alpha; }
#pragma unroll
            for (int s = 0; s < 4; ++s) {
                u32x4 pw;
                if (s == 0) { pw.x = pk2(p0[0], p0[1]); pw.y = pk2(p0[2], p0[3]); pw.z = pk2(p0[4], p0[5]); pw.w = pk2(p0[6], p0[7]); }
                else if (s == 1) { pw.x = pk2(p0[8], p0[9]); pw.y = pk2(p0[10], p0[11]); pw.z = pk2(p0[12], p0[13]); pw.w = pk2(p0[14], p0[15]); }
                else if (s == 2) { pw.x = pk2(p1[0], p1[1]); pw.y = pk2(p1[2], p1[3]); pw.z = pk2(p1[4], p1[5]); pw.w = pk2(p1[6], p1[7]); }
                else { pw.x = pk2(p1[8], p1[9]); pw.y = pk2(p1[10], p1[11]); pw.z = pk2(p1[12], p1[13]); pw.w = pk2(p1[14], p1[15]); }
                const bf16x8 pb = __builtin_bit_cast(bf16x8, pw);
                const LAS unsigned char* vp = vb + r32 * VSTR + (16 * s + 4 * hi) * 2;
                const u32x2 l0 = *(const LAS u32x2*)vp, h0 = *(const LAS u32x2*)(vp + 16);
                const u32x2 l1 = *(const LAS u32x2*)(vp + 32 * VSTR), h1 = *(const LAS u32x2*)(vp + 32 * VSTR + 16);
                const bf16x8 va0 = __builtin_bit_cast(bf16x8, (u32x4){l0.x, l0.y, h0.x, h0.y});
                const bf16x8 va1 = __builtin_bit_cast(bf16x8, (u32x4){l1.x, l1.y, h1.x, h1.y});
                o0 = __builtin_amdgcn_mfma_f32_32x32x16_bf16(va0, pb, o0, 0, 0, 0);
                o1 = __builtin_amdgcn_mfma_f32_32x32x16_bf16(va1, pb, o1, 0, 0, 0);
            }
            if (more) ATT_STORE((t + 1) & 1);
            __syncthreads();
        }
#undef ATT_LOAD
#undef ATT_STORE
        const float ltot = lrow + __shfl_xor(lrow, 32);
        const float inv = 1.0f / ltot;
        bf16_t* orow = CAT + (size_t)qrow * DM + 512 + h * 64 + 4 * hi;
#pragma unroll
        for (int g = 0; g < 4; ++g) {
            u32x2 w0; w0.x = pk2(o0[4 * g] * inv, o0[4 * g + 1] * inv); w0.y = pk2(o0[4 * g + 2] * inv, o0[4 * g + 3] * inv);
            u32x2 w1; w1.x = pk2(o1[4 * g] * inv, o1[4 * g + 1] * inv); w1.y = pk2(o1[4 * g + 2] * inv, o1[4 * g + 3] * inv);
            *(u32x2*)(orow + 8 * g) = w0; *(u32x2*)(orow + 32 + 8 * g) = w1;
        }
    }
}


#define XB_TMO      128
#define XB_XCNT(j)  (256  + 64 * (j))
#define XB_XSUB(j)  (1280 + 64 * (j))
#define XB_XGEN(j)  (2304 + 64 * (j))
#define XB_TOP      3328
#define XB_TOPGEN   3392
#define XCD_BAR_WORDS 3456
#define XB_SPIN_CAP (1u << 18)
__device__ __forceinline__ unsigned xb_ld(unsigned* p)              { return __hip_atomic_load(p, __ATOMIC_RELAXED, __HIP_MEMORY_SCOPE_AGENT); }
__device__ __forceinline__ unsigned xb_add(unsigned* p, unsigned v) { return __hip_atomic_fetch_add(p, v, __ATOMIC_RELAXED, __HIP_MEMORY_SCOPE_AGENT); }
__device__ __forceinline__ unsigned xb_xcc_id() { return (unsigned)__builtin_amdgcn_s_getreg((3 << 11) | 20) & 0xFu; }
#define XB_SPIN(cond, bar) do { unsigned _sp = 0; while (cond) { __builtin_amdgcn_s_sleep(1); \
    if ((++_sp & 255u) == 0u) { if (xb_ld(&(bar)[XB_TMO])) break; if (_sp > XB_SPIN_CAP) { atomicAdd(&(bar)[XB_TMO], 1u); break; } } } } while (0)
struct XcdBarrier { unsigned* bar; unsigned x; volatile LAS unsigned* st; };
__device__ __forceinline__ void xcd_barrier_post(XcdBarrier& b, int tid) { if (tid == 0) (void)xb_add(&b.bar[XB_XCNT(b.x)], 1u); }
__device__ __forceinline__ void xcd_barrier_complete(unsigned* bar, unsigned x, unsigned& nloc, unsigned& nx) {
    const unsigned G = gridDim.x * gridDim.y * gridDim.z;
    unsigned sum, cnt, mine, sp = 0u;
    for (;;) {
        sum = 0u; cnt = 0u; mine = 0u;
#pragma unroll
        for (unsigned j = 0; j < 16; ++j) { const unsigned c = xb_ld(&bar[XB_XCNT(j)]); sum += c; cnt += (c > 0u) ? 1u : 0u; mine = (j == x) ? c : mine; }
        if (sum == G) break;
        __builtin_amdgcn_s_sleep(1);
        if ((++sp & 255u) == 0u) { if (xb_ld(&bar[XB_TMO])) break; if (sp > XB_SPIN_CAP) { atomicAdd(&bar[XB_TMO], 1u); break; } }
    }
    nloc = mine > 0u ? mine : 1u; nx = cnt > 0u ? cnt : 1u;
}
__device__ __forceinline__ void xcd_barrier(const XcdBarrier& b, int tid) {
    asm volatile("s_waitcnt vmcnt(0)" ::: "memory");
    __syncthreads();
    if (tid == 0) {
        unsigned* bar = b.bar;
        __builtin_amdgcn_s_waitcnt(0);
        unsigned nloc = b.st[0], nx = b.st[1];
        if (nloc == 0u) { xcd_barrier_complete(bar, b.x, nloc, nx); b.st[0] = nloc; b.st[1] = nx; }
        const unsigned old = xb_add(&bar[XB_XSUB(b.x)], 1u);
        const unsigned gen = old / nloc;
        if (old + 1u == (gen + 1u) * nloc) {
            __builtin_amdgcn_fence(__ATOMIC_RELEASE, "agent");
            asm volatile("s_waitcnt vmcnt(0)" ::: "memory");
            const unsigned og = xb_add(&bar[XB_TOP], 1u);
            const unsigned tg = og / nx;
            if (og + 1u == (tg + 1u) * nx) xb_add(&bar[XB_TOPGEN], 1u);
            else XB_SPIN(xb_ld(&bar[XB_TOPGEN]) == tg, bar);
            __builtin_amdgcn_fence(__ATOMIC_ACQUIRE, "agent");
            xb_add(&bar[XB_XGEN(b.x)], 1u);
            asm volatile("s_waitcnt vmcnt(0)" ::: "memory");
        } else {
            XB_SPIN(xb_ld(&bar[XB_XGEN(b.x)]) == gen, bar);
            __builtin_amdgcn_fence(__ATOMIC_ACQUIRE, "agent");
            asm volatile("s_waitcnt vmcnt(0)" ::: "memory");
        }
    }
    __syncthreads();
}

__global__ void __launch_bounds__(512, 2) mega_fwd(Args a) {
    extern __shared__ __attribute__((aligned(16))) unsigned char lds_raw[];
    LAS unsigned char* lds = (LAS unsigned char*)lds_raw;
    cg::grid_group grid = cg::this_grid();
    const int G = gridDim.x, bx = blockIdx.x;
    const int vcu = (G % 8 == 0) ? (bx % 8) * (G / 8) + bx / 8 : bx;

    bool rep_done = false;
    volatile LAS unsigned* bst = (volatile LAS unsigned*)(lds + 131072 + 512);
    if (threadIdx.x == 0) { bst[0] = 0u; bst[1] = 0u; }
    __syncthreads();
    XcdBarrier xbar; xbar.bar = (unsigned*)(a.ws + WS_BAR); xbar.x = xb_xcc_id(); xbar.st = bst;
    bool posted = false;
    if (a.st_lo == 0 && bx == 0) { for (int e = threadIdx.x; e < XCD_BAR_WORDS; e += 512) xbar.bar[e] = 0u; }
#define SEAM() do { if (!posted) { grid.sync(); xcd_barrier_post(xbar, (int)threadIdx.x); posted = true; } else xcd_barrier(xbar, (int)threadIdx.x); } while (0)
    for (int st = a.st_lo; st < a.st_hi; ++st) {
        int zero = 0; asm volatile("" : "+s"(zero));
        int tid_op = threadIdx.x; asm volatile("" : "+v"(tid_op));
        unsigned char* ws = a.ws + zero;
        float* MOD = (float*)(ws + WS_MOD);
        float* ROPE = (float*)(ws + WS_ROPE);
        float* RSQ = (float*)(ws + WS_RSQ);
        float* RSKV = (float*)(ws + WS_RSKV);
        bf16_t* U = (bf16_t*)(ws + WS_U);
        bf16_t* ACT = (bf16_t*)(ws + WS_ACT);
        bf16_t* T1 = (bf16_t*)(ws + WS_T1);
        float* Gs = (float*)(ws + WS_G);
        float* H = a.out + zero;
        int kind = 0;
        bool sync_after = true;
        const bf16_t* gA = nullptr; const bf16_t* gB = nullptr; int g_lda = 0, g_ldb = 0, g_M = 0, g_N = 0, g_K = 0, g_tp0 = 0, g_tnp = 0;
        int e_mode = 0, e_ldc = 0; float e_f0 = 0.f; void* e_p0 = nullptr; const void* e_p1 = nullptr; const void* e_p2 = nullptr; const void* e_p3 = nullptr;
        int rot = 0;
        switch (st) {
            case 0: prologue_step(a, lds, G, zero, tid_op); break;
            case 1: norm_step(INP(0), INP(2), MALL, INP(4) + 0 * DM, MOD, 0, U, H, Gs, nullptr, 0, nullptr, 0.f, G, tid_op); break;
            case 13: norm_step(H, Gs, MH, INP(4) + 2 * DM, MOD, 2, U, nullptr, nullptr, nullptr, 0, nullptr, 0.f, G, tid_op); break;
            case 4: { int ps_ = 256 / 32; if (G % 32 != 0) ps_ = 1; norm_step(H, Gs, MALL, INP(4) + 1 * DM, MOD, 1, U, nullptr, nullptr, (const float*)(ws + WS_PART), ps_, MOD + 8 * 9216 + 2 * 1024, 0.5f, G, tid_op); } break;
            case 2: case 14: case 17: case 24: {
                const int ls = (st == 2) ? 0 : (st == 14) ? 1 : (st == 17) ? 2 : 3;
                kind = 1; gA = U; gB = (const bf16_t*)(ws + WS_BGU) + (size_t)ls * 5632 * 1024; g_lda = DM; g_ldb = DM; g_M = ls < 1 ? MALL : MH; g_N = 2 * FF; g_K = DM;
                e_mode = 1; e_p0 = ACT; e_ldc = FF; break; }
            case 3: case 15: case 18: case 25: {
                const int ls = (st == 3) ? 0 : (st == 15) ? 1 : (st == 18) ? 2 : 3;
                kind = 1; gA = ACT; gB = (const bf16_t*)(ws + WS_BD) + (size_t)ls * 1024 * 2816; g_lda = FF; g_ldb = FF; g_M = MH; g_N = DM; g_K = FF; if (st == 3) { g_tp0 = MH / 256; g_tnp = MG / 256; e_p2 = (const void*)(ws + WS_PART); }
                e_mode = 3; e_p0 = H; e_p1 = MOD + (size_t)(ls >> 1) * 82944 + ((ls & 1) ? 8 : 2) * 1024; e_f0 = 0.5f; break; }
            case 5: kind = 1; gA = U; gB = (const bf16_t*)(ws + WS_BIN); g_lda = DM; g_ldb = DM; g_M = MALL; g_N = NIN; g_K = DM; e_mode = 0; e_p0 = T1; e_ldc = NIN; break;
            case 6: prep_step(T1, RSQ, RSKV, (bf16_t*)(ws + WS_KR), (bf16_t*)(ws + WS_P), ROPE, G, tid_op); break;
            case 7: kind = 1; sync_after = false; gA = T1 + 512; gB = (const bf16_t*)(ws + WS_BUQ); g_lda = NIN; g_ldb = QW; g_M = MH; g_N = QW; g_K = QW;
                e_mode = 0; e_p0 = (ws + WS_Q); e_ldc = QW; e_p1 = RSQ; e_f0 = QSCALE; e_p3 = ROPE; break;
            case 8: kind = 1; sync_after = false; rot = 64; gA = T1 + 1280; gB = (const bf16_t*)(ws + WS_BKV); g_lda = NIN; g_ldb = 256; g_M = MALL; g_N = 512; g_K = 256;
                e_mode = 0; e_p0 = (ws + WS_K); e_ldc = 512; e_p1 = RSKV; e_f0 = 1.0f; break;
            case 9: kind = 1; sync_after = false; rot = 176; gA = (const bf16_t*)(ws + WS_BKV) + (size_t)512 * 256; gB = T1 + 1280; g_lda = 256; g_ldb = NIN; g_M = 512; g_N = MALL; g_K = 256;
                e_mode = 0; e_p0 = (ws + WS_VT); e_ldc = MALL; e_p2 = RSKV; break;
            case 10: kind = 1; rot = 32; gA = (const bf16_t*)(ws + WS_P); gB = (const bf16_t*)(ws + WS_BPOOL); g_lda = 512; g_ldb = 512; g_M = MH; g_N = 512; g_K = 512;
                e_mode = 0; e_p0 = U; e_ldc = DM; break;
            case 11: attn_step(lds, (const bf16_t*)(ws + WS_Q), (const bf16_t*)(ws + WS_K), (const bf16_t*)(ws + WS_KR), (const bf16_t*)(ws + WS_VT), U, vcu, G, tid_op); break;
            case 12: kind = 1; gA = U; gB = (const bf16_t*)(ws + WS_BOUT); g_lda = DM; g_ldb = DM; g_M = MH; g_N = DM; g_K = DM;
                e_mode = 3; e_p0 = H; e_p1 = MOD + 5 * 1024; e_f0 = 1.0f; break;
            case 16: norm_step(H, Gs, MH, INP(4) + 3 * DM, MOD + 82944, 0, U, nullptr, nullptr, nullptr, 0, nullptr, 0.f, G, tid_op); break;
            case 19: norm_step(H, Gs, MH, INP(4) + 4 * DM, MOD + 82944, 1, U, nullptr, nullptr, nullptr, 0, nullptr, 0.f, G, tid_op); break;
            case 23: norm_step(H, Gs, MH, INP(4) + 5 * DM, MOD + 82944, 2, U, nullptr, nullptr, nullptr, 0, nullptr, 0.f, G, tid_op); break;
            case 20: kind = 1; gA = U; gB = (const bf16_t*)(ws + WS_BCIN); g_lda = DM; g_ldb = DM; g_M = MH; g_N = 3072; g_K = DM; e_mode = 2; e_p0 = (ws + WS_Z); e_ldc = DM; e_p1 = (ws + WS_BGATE); break;
            case 21: convew_step((const bf16_t*)(ws + WS_Z), (const bf16_t*)(ws + WS_BGATE), INP(19), (bf16_t*)(ws + WS_A2), G, tid_op); break;
            case 22: kind = 1; gA = (const bf16_t*)(ws + WS_A2); gB = (const bf16_t*)(ws + WS_BCOUT); g_lda = DM; g_ldb = DM; g_M = MH; g_N = DM; g_K = DM;
                e_mode = 3; e_p0 = H; e_p1 = MOD + 82944 + 5 * 1024; e_f0 = 1.0f; break;
            case 26: final_norm_step(H, INP(21), G, tid_op); sync_after = false; break;
            default: break;
        }
        if (kind == 1) { const int c = (bx + rot) % G; const pg8::Gemm g{gA, gB, g_lda, g_ldb, g_M, g_N, g_K, g_tp0, g_tnp}; const pg8::Epi E{e_mode, e_ldc, e_f0, 0.f, e_p0, e_p1, e_p2, e_p3}; pg8::gemm_phase(lds, g, G, c, E, tid_op); }
        if (sync_after && st + 1 < a.st_hi) SEAM();
        if (MK_REPEAT_MASK != 0u) { if (((MK_REPEAT_MASK >> st) & 1u) && !rep_done) { rep_done = true; --st; if (!sync_after) SEAM(); } else rep_done = false; }
    }
}

extern "C" void kernel_launch(void* const* d_in, const int* in_sizes, int n_in, void* d_out, int out_size, void* d_ws, size_t ws_size, hipStream_t stream) {
    static int grid = 0;
    if (grid == 0) {
        if (n_in != 22 || ws_size < WS_END) { fprintf(stderr, "kernel_launch: unexpected n_in %d / ws_size %zu\n", n_in, ws_size); grid = -1; return; }
        int dev = 0, cus = 0, per_cu = 0;
        hipGetDevice(&dev);
        hipDeviceGetAttribute(&cus, hipDeviceAttributeMultiprocessorCount, dev);
        hipFuncSetAttribute((const void*)mega_fwd, hipFuncAttributeMaxDynamicSharedMemorySize, LDS_BYTES);
        hipOccupancyMaxActiveBlocksPerMultiprocessor(&per_cu, (const void*)mega_fwd, 512, LDS_BYTES);
        if (per_cu < 1) { fprintf(stderr, "kernel_launch: occupancy query says %d blocks per CU\n", per_cu); per_cu = 1; }
        (void)hipGetLastError();
        grid = cus;
    }
    if (grid < 0) return;
    Args a{};
    for (int i = 0; i < 22; ++i) a.in[i] = (const float*)d_in[i];
    a.out = (float*)d_out; a.ws = (unsigned char*)d_ws;
#if MK_PER_STEP
    for (int s = 0; s < NSTEPS; ++s) {
        a.st_lo = s; a.st_hi = s + 1;
        hipLaunchKernelGGL(mega_fwd, dim3(grid), dim3(512), LDS_BYTES, stream, a);
    }
#else
    a.st_lo = 0; a.st_hi = NSTEPS;
    void* args[] = {&a};
    hipError_t e = hipLaunchCooperativeKernel((const void*)mega_fwd, dim3(grid), dim3(512), args, LDS_BYTES, stream);
    if (e != hipSuccess) fprintf(stderr, "cooperative launch failed: %s (grid %d)\n", hipGetErrorString(e), grid);
#endif
}
```
